# Optimizing an MI355X kernel written in HIP

```python
import jax, jax.numpy as jnp
from jax import lax
import numpy as np

D_MODEL = 1024
BATCH = 4
SEQ = 4096
DEPTH = 2

GRID_W = 64
CTX_LEN = 256
N_MIXERS = 2
N_POOL_LAYERS = (DEPTH + N_MIXERS - 1) // N_MIXERS
N_ATTN_LAYERS = DEPTH // N_MIXERS
POOL_WINDOWS = (2, 4, 8, 16)
N_POOL_GROUPS = len(POOL_WINDOWS)
POOL_GROUP_DIM = D_MODEL // N_POOL_GROUPS
HEAD_DIM = 64
N_HEADS = D_MODEL // HEAD_DIM
N_KV_HEADS = 2
GQA_GROUP = N_HEADS // N_KV_HEADS
Q_DIM = N_HEADS * HEAD_DIM
KV_DIM = N_KV_HEADS * HEAD_DIM
WINDOW = 128
BLOCK = 128
ROPE_BASE = 10000.0
AXIS_ROT = HEAD_DIM // 2
D_FF = 4 * D_MODEL
N_MOD = 6
EPS = 1e-6
NEG = -1e30

kernel_name = 'hybrid_pool_swa_dit_block'


def rmsnorm(x, g):
    xf = x.astype(jnp.float32)
    y = xf * lax.rsqrt(jnp.mean(xf * xf, axis=-1, keepdims=True) + EPS)
    return (y * g.astype(jnp.float32)).astype(x.dtype)


def modulate(h, shift, scale):
    return h * (1 + scale) + shift


def pool_minus_self(u):
    B, L, G, C = u.shape
    uf = u.astype(jnp.float32)
    cs = jnp.concatenate([jnp.zeros((B, 1, G, C), jnp.float32), lax.cumsum(uf, axis=1)], axis=1)
    t = jnp.arange(L)
    outs = []
    for g, w in enumerate(POOL_WINDOWS):
        lo = jnp.clip(t - w // 2, 0, L)
        hi = jnp.clip(t + w // 2, 0, L)
        cnt = (hi - lo).astype(jnp.float32)
        csg = cs[:, :, g]
        s = jnp.take(csg, hi, axis=1) - jnp.take(csg, lo, axis=1)
        outs.append(s / cnt[None, :, None])
    pooled = jnp.stack(outs, axis=2)
    return (pooled - uf).astype(u.dtype)


def pool_mixer(h, w_in, w_grp, scale, w_out):
    B, L, _ = h.shape
    u = (h @ w_in).reshape(B, L, N_POOL_GROUPS, POOL_GROUP_DIM)
    d = pool_minus_self(u)
    y = jnp.einsum('blgc,gce->blge', d, w_grp).reshape(B, L, D_MODEL) * scale
    return y @ w_out


def axial_angles(L):
    rows = L // GRID_W
    row = jnp.repeat(jnp.arange(rows), GRID_W).astype(jnp.float32)
    col = jnp.tile(jnp.arange(GRID_W), rows).astype(jnp.float32)
    inv = ROPE_BASE ** (-jnp.arange(0, AXIS_ROT, 2, dtype=jnp.float32) / AXIS_ROT)
    ang_r = row[:, None] * inv[None]
    ang_c = col[:, None] * inv[None]
    return (jnp.cos(ang_r), jnp.sin(ang_r), jnp.cos(ang_c), jnp.sin(ang_c))


def rotate_axis(u, cos, sin):
    r = u.shape[-1] // 2
    u1, u2 = u[..., :r], u[..., r:]
    cos = cos[:, None, :].astype(u.dtype)
    sin = sin[:, None, :].astype(u.dtype)
    return jnp.concatenate([u1 * cos - u2 * sin, u1 * sin + u2 * cos], axis=-1)


def rope_2d(t, ang):
    cos_r, sin_r, cos_c, sin_c = ang
    return jnp.concatenate([rotate_axis(t[..., :AXIS_ROT], cos_r, sin_r),
                            rotate_axis(t[..., AXIS_ROT:], cos_c, sin_c)], axis=-1)


def window_attention(h, hc, w_qkv, sink, w_o, ang, with_ctx_out):
    B, L, _ = h.shape
    ctx_len = hc.shape[1]
    nb = L // BLOCK
    qscale = HEAD_DIM ** -0.5
    qkv = h @ w_qkv
    q = qkv[..., :Q_DIM].reshape(B, L, N_HEADS, HEAD_DIM)
    k = qkv[..., Q_DIM:Q_DIM + KV_DIM].reshape(B, L, N_KV_HEADS, HEAD_DIM)
    v = qkv[..., Q_DIM + KV_DIM:].reshape(B, L, N_KV_HEADS, HEAD_DIM)
    q = rope_2d(q, ang) * qscale
    k = rope_2d(k, ang)
    kv_c = hc @ w_qkv[:, Q_DIM:]
    kc = kv_c[..., :KV_DIM].reshape(B, ctx_len, N_KV_HEADS, HEAD_DIM)
    vc = kv_c[..., KV_DIM:].reshape(B, ctx_len, N_KV_HEADS, HEAD_DIM)

    qb = q.reshape(B, nb, BLOCK, N_KV_HEADS, GQA_GROUP, HEAD_DIM)

    def band(t):
        tp = jnp.pad(t, ((0, 0), (BLOCK, BLOCK), (0, 0), (0, 0)))
        tp = tp.reshape(B, nb + 2, BLOCK, N_KV_HEADS, HEAD_DIM)
        return jnp.concatenate([tp[:, :-2], tp[:, 1:-1], tp[:, 2:]], axis=2)

    kw, vw = band(k), band(v)
    s_win = jnp.einsum('bnqhgd,bnkhd->bnhgqk', qb, kw).astype(jnp.float32)
    qpos = jnp.arange(L).reshape(nb, BLOCK)
    kpos = (jnp.arange(nb) * BLOCK - BLOCK)[:, None] + jnp.arange(3 * BLOCK)[None, :]
    valid = ((kpos >= 0) & (kpos < L))[:, None, :] & (jnp.abs(qpos[:, :, None] - kpos[:, None, :]) <= WINDOW)
    s_win = jnp.where(valid[None, :, None, None], s_win, NEG)
    s_ctx = jnp.einsum('bnqhgd,bchd->bnhgqc', qb, kc).astype(jnp.float32)
    sink_f = sink.astype(jnp.float32).reshape(1, 1, N_KV_HEADS, GQA_GROUP, 1, 1)
    s_sink = jnp.broadcast_to(sink_f, s_win.shape[:-1] + (1,))
    p = jax.nn.softmax(jnp.concatenate([s_win, s_ctx, s_sink], axis=-1), axis=-1)
    p_win = p[..., :3 * BLOCK].astype(v.dtype)
    p_ctx = p[..., 3 * BLOCK:3 * BLOCK + ctx_len].astype(v.dtype)
    o = (jnp.einsum('bnhgqk,bnkhd->bnqhgd', p_win, vw)
         + jnp.einsum('bnhgqc,bchd->bnqhgd', p_ctx, vc))
    y = o.reshape(B, L, Q_DIM) @ w_o

    yc = None
    if with_ctx_out:
        qc = (hc @ w_qkv[:, :Q_DIM]).reshape(B, ctx_len, N_KV_HEADS, GQA_GROUP, HEAD_DIM) * qscale
        sc = jnp.einsum('bqhgd,bchd->bhgqc', qc, kc).astype(jnp.float32)
        sc_sink = jnp.broadcast_to(sink.astype(jnp.float32).reshape(1, N_KV_HEADS, GQA_GROUP, 1, 1),
                                   sc.shape[:-1] + (1,))
        pc = jax.nn.softmax(jnp.concatenate([sc, sc_sink], axis=-1), axis=-1)
        oc = jnp.einsum('bhgqc,bchd->bqhgd', pc[..., :ctx_len].astype(vc.dtype), vc)
        yc = oc.reshape(B, ctx_len, Q_DIM) @ w_o
    return y, yc


def sq_relu_mlp(h, w1, w2):
    return jnp.square(jax.nn.relu(h @ w1)) @ w2


def setup_inputs(seed: int = 0) -> dict:
    key = jax.random.key(seed)
    ks = jax.random.split(key, 20)
    nrm = jax.random.normal
    f32 = jnp.float32
    return {
        'x': nrm(ks[0], (BATCH, SEQ, D_MODEL), f32),
        'c': nrm(ks[1], (BATCH, D_MODEL), f32),
        'ctx': nrm(ks[2], (BATCH, CTX_LEN, D_MODEL), f32),
        'c_ctx': nrm(ks[3], (D_MODEL,), f32),
        'ada_w': nrm(ks[4], (DEPTH, D_MODEL, N_MOD * D_MODEL), f32) * (0.5 * D_MODEL ** -0.5),
        'ada_b': nrm(ks[5], (DEPTH, N_MOD * D_MODEL), f32) * 0.01,
        'norm_mix_g': 1.0 + 0.05 * nrm(ks[6], (DEPTH, D_MODEL), f32),
        'norm_mlp_g': 1.0 + 0.05 * nrm(ks[7], (DEPTH, D_MODEL), f32),
        'pool_w_in': nrm(ks[8], (N_POOL_LAYERS, D_MODEL, D_MODEL), f32) * D_MODEL ** -0.5,
        'pool_w_grp': nrm(ks[9], (N_POOL_LAYERS, N_POOL_GROUPS, POOL_GROUP_DIM, POOL_GROUP_DIM), f32) * POOL_GROUP_DIM ** -0.5,
        'pool_scale': 1.0 + 0.1 * nrm(ks[10], (N_POOL_LAYERS, D_MODEL), f32),
        'pool_w_out': nrm(ks[11], (N_POOL_LAYERS, D_MODEL, D_MODEL), f32) * D_MODEL ** -0.5,
        'attn_w_qkv': nrm(ks[12], (N_ATTN_LAYERS, D_MODEL, Q_DIM + 2 * KV_DIM), f32) * D_MODEL ** -0.5,
        'attn_sink': 0.5 * nrm(ks[13], (N_ATTN_LAYERS, N_HEADS), f32),
        'attn_w_o': nrm(ks[14], (N_ATTN_LAYERS, Q_DIM, D_MODEL), f32) * Q_DIM ** -0.5,
        'mlp_w1': nrm(ks[15], (DEPTH, D_MODEL, D_FF), f32) * D_MODEL ** -0.5,
        'mlp_w2': nrm(ks[16], (DEPTH, D_FF, D_MODEL), f32) * D_FF ** -0.5,
        'final_g': 1.0 + 0.05 * nrm(ks[17], (D_MODEL,), f32),
    }


def reference(x, c, ctx, c_ctx, ada_w, ada_b, norm_mix_g, norm_mlp_g, pool_w_in, pool_w_grp,
              pool_scale, pool_w_out, attn_w_qkv, attn_sink, attn_w_o, mlp_w1, mlp_w2, final_g):
    L = x.shape[1]
    ang = axial_angles(L)
    silu_c = jax.nn.silu(c)
    silu_cc = jax.nn.silu(c_ctx)[None]
    for i in range(DEPTH):
        last = i == DEPTH - 1
        kind = i % N_MIXERS
        j = i // N_MIXERS
        mod = (silu_c @ ada_w[i] + ada_b[i])[:, None, :]
        mod_c = (silu_cc @ ada_w[i] + ada_b[i])[:, None, :]
        sh1, sc1, g1, sh2, sc2, g2 = jnp.split(mod, N_MOD, axis=-1)
        csh1, csc1, cg1, csh2, csc2, cg2 = jnp.split(mod_c, N_MOD, axis=-1)

        h = modulate(rmsnorm(x, norm_mix_g[i]), sh1, sc1)
        if kind == 0:
            y = pool_mixer(h, pool_w_in[j], pool_w_grp[j], pool_scale[j], pool_w_out[j])
            if not last:
                hc = modulate(rmsnorm(ctx, norm_mix_g[i]), csh1, csc1)
                yc = pool_mixer(hc, pool_w_in[j], pool_w_grp[j], pool_scale[j], pool_w_out[j])
        else:
            hc = modulate(rmsnorm(ctx, norm_mix_g[i]), csh1, csc1)
            y, yc = window_attention(h, hc, attn_w_qkv[j], attn_sink[j], attn_w_o[j], ang, not last)

        x = x + g1 * y
        h = modulate(rmsnorm(x, norm_mlp_g[i]), sh2, sc2)
        x = x + g2 * sq_relu_mlp(h, mlp_w1[i], mlp_w2[i])

        if not last:
            ctx = ctx + cg1 * yc
            hc = modulate(rmsnorm(ctx, norm_mlp_g[i]), csh2, csc2)
            ctx = ctx + cg2 * sq_relu_mlp(hc, mlp_w1[i], mlp_w2[i])
    return rmsnorm(x, final_g)
```

```cpp
#include <hip/hip_runtime.h>
#include <cstdio>
#include <cstdint>

constexpr int D = 1024, BATCH = 4, SEQ = 4096, CTXL = 256, FF = 4096, NMOD = 6;
constexpr int ML = BATCH * SEQ;
constexpr int MC = BATCH * CTXL;
constexpr int MA = ML + MC;
constexpr int NQKV = 1280, QDIM = 1024, KVD = 128, HD = 64, NH = 16, NKV = 2;
constexpr float EPS = 1e-6f;
constexpr float QS = 0.125f * 1.4426950408889634f;
constexpr float LOG2E = 1.4426950408889634f;
constexpr int NWAVES = 8;

constexpr size_t MiB = 1u << 20;
constexpr size_t WS_CTL = 0, CTL_ZERO_BYTES = 1 * MiB;
constexpr size_t WS_MOD = 1 * MiB;
constexpr size_t WS_ROPE = 1 * MiB + 512 * 1024;
constexpr size_t WS_WIN = 2 * MiB, WS_WGRP = 4 * MiB, WS_WOUT = 5 * MiB, WS_WQKV = 7 * MiB, WS_WO = 10 * MiB;
constexpr size_t WS_W1 = 12 * MiB  , WS_W2 = 28 * MiB  ;
constexpr size_t WS_CX = 44 * MiB;
constexpr size_t WS_XN = 48 * MiB;
constexpr size_t WS_R = 82 * MiB;
constexpr size_t WS_U = WS_R, WS_DP = WS_R + 34 * MiB, WS_Y1 = WS_R + 68 * MiB;
constexpr size_t WS_H = WS_R;
constexpr size_t WS_Q = WS_R, WS_K = WS_R + 32 * MiB, WS_V = WS_R + 36 * MiB, WS_KC = WS_R + 40 * MiB, WS_VC = WS_KC + 256 * 1024, WS_O = WS_R + 42 * MiB;
constexpr size_t WS_RAW = 160 * MiB;
constexpr size_t WS_END = 256 * MiB;
constexpr int CW_BAR = 4096;

constexpr int RING_BYTES = 131072;
constexpr int LDSCTL_OFF = RING_BYTES, MISC_OFF = LDSCTL_OFF + 320;
constexpr int LDS_BYTES = 147456;

#define GAS __attribute__((address_space(1)))
#define LAS __attribute__((address_space(3)))
typedef unsigned short bf16;
typedef unsigned v4u __attribute__((ext_vector_type(4)));
typedef unsigned v2u __attribute__((ext_vector_type(2)));
typedef float f32x4 __attribute__((ext_vector_type(4)));
typedef short bf16x8 __attribute__((ext_vector_type(8)));
typedef GAS unsigned gu32;
#define RLX_AGENT __ATOMIC_RELAXED, __HIP_MEMORY_SCOPE_AGENT
#define LDS_WAIT() asm volatile("s_waitcnt lgkmcnt(0)" ::: "memory")
#define VM_WAIT() asm volatile("s_waitcnt vmcnt(0)" ::: "memory")
__device__ __forceinline__ unsigned f2bf(float f) { unsigned u = __builtin_bit_cast(unsigned, f); return (u + 0x7fffu + ((u >> 16) & 1u)) >> 16; }
__device__ __forceinline__ unsigned pk2(float lo, float hi) { return f2bf(lo) | (f2bf(hi) << 16); }
__device__ __forceinline__ float bf2f(unsigned short b) { return __builtin_bit_cast(float, (unsigned)b << 16); }

#define XB_TMO      128
#define XB_XCNT(j)  (256  + 64 * (j))
#define XB_XSUB(j)  (1280 + 64 * (j))
#define XB_XGEN(j)  (2304 + 64 * (j))
#define XB_TOP      3328
#define XB_TOPGEN   3392
#define XCD_BAR_WORDS 3456
#define XB_SPIN_CAP (1u << 18)

__device__ __forceinline__ unsigned xb_ld(unsigned* p)              { return __hip_atomic_load(p, __ATOMIC_RELAXED, __HIP_MEMORY_SCOPE_AGENT); }
__device__ __forceinline__ unsigned xb_add(unsigned* p, unsigned v) { return __hip_atomic_fetch_add(p, v, __ATOMIC_RELAXED, __HIP_MEMORY_SCOPE_AGENT); }
__device__ __forceinline__ unsigned xb_xcc_id() { return (unsigned)__builtin_amdgcn_s_getreg((3 << 11) | 20) & 0xFu; }
#define XB_SPIN(cond, bar) do { unsigned _sp = 0; while (cond) { __builtin_amdgcn_s_sleep(1); \
    if ((++_sp & 255u) == 0u) { if (xb_ld(&(bar)[XB_TMO])) break; if (_sp > XB_SPIN_CAP) { atomicAdd(&(bar)[XB_TMO], 1u); break; } } } } while (0)

struct XcdBarrier {
    unsigned* bar; unsigned x;
    volatile LAS unsigned* st;
};

__device__ __forceinline__ XcdBarrier xcd_barrier_post(unsigned* bar, volatile LAS unsigned* st) {
    XcdBarrier b; b.bar = bar; b.x = xb_xcc_id(); b.st = st;
    if (threadIdx.x == 0) (void)xb_add(&bar[XB_XCNT(b.x)], 1u);
    return b;
}
__device__ __forceinline__ void xcd_barrier_complete(unsigned* bar, unsigned x, unsigned& nloc, unsigned& nx) {
    const unsigned G = gridDim.x * gridDim.y * gridDim.z;
    unsigned sum, cnt, mine, sp = 0u;
    for (;;) {
        sum = 0u; cnt = 0u; mine = 0u;
#pragma unroll
        for (unsigned j = 0; j < 16; ++j) { const unsigned c = xb_ld(&bar[XB_XCNT(j)]); sum += c; cnt += (c > 0u) ? 1u : 0u; mine = (j == x) ? c : mine; }
        if (sum == G) break;
        __builtin_amdgcn_s_sleep(1);
        if ((++sp & 255u) == 0u) { if (xb_ld(&bar[XB_TMO])) break; if (sp > XB_SPIN_CAP) { atomicAdd(&bar[XB_TMO], 1u); break; } }
    }
    nloc = mine > 0u ? mine : 1u; nx = cnt > 0u ? cnt : 1u;
}

__device__ __forceinline__ void xcd_barrier(const XcdBarrier& b) {
    asm volatile("s_waitcnt vmcnt(0)" ::: "memory");
    __syncthreads();
    if (threadIdx.x == 0) {
        unsigned* bar = b.bar;
        __builtin_amdgcn_s_waitcnt(0);
        unsigned nloc = b.st[0], nx = b.st[1];
        if (nloc == 0u) { xcd_barrier_complete(bar, b.x, nloc, nx); b.st[0] = nloc; b.st[1] = nx; }
        const unsigned old = xb_add(&bar[XB_XSUB(b.x)], 1u);
        const unsigned gen = old / nloc;
        if (old + 1u == (gen + 1u) * nloc) {
            __builtin_amdgcn_fence(__ATOMIC_RELEASE, "agent");
            asm volatile("s_waitcnt vmcnt(0)" ::: "memory");
            const unsigned og = xb_add(&bar[XB_TOP], 1u);
            const unsigned tg = og / nx;
            if (og + 1u == (tg + 1u) * nx) xb_add(&bar[XB_TOPGEN], 1u);
            else XB_SPIN(xb_ld(&bar[XB_TOPGEN]) == tg, bar);
            __builtin_amdgcn_fence(__ATOMIC_ACQUIRE, "agent");
            xb_add(&bar[XB_XGEN(b.x)], 1u);
            asm volatile("s_waitcnt vmcnt(0)" ::: "memory");
        } else {
            XB_SPIN(xb_ld(&bar[XB_XGEN(b.x)]) == gen, bar);
            __builtin_amdgcn_fence(__ATOMIC_ACQUIRE, "agent");
            asm volatile("s_waitcnt vmcnt(0)" ::: "memory");
        }
    }
    __syncthreads();
}

struct Frame {
    LAS unsigned char* lds;
    volatile LAS unsigned* MISC;
    gu32* ctl;
    int tid, lane, wave;
    int vcu, G;
    unsigned char* ws;
    const float* in[18];
    float* out;
};
enum { I_X = 0, I_C, I_CTX, I_CCTX, I_ADAW, I_ADAB, I_NMIXG, I_NMLPG, I_PWIN, I_PWGRP, I_PSCALE, I_PWOUT, I_WQKV, I_SINK, I_WO, I_W1, I_W2, I_FING };

__device__ __forceinline__ float wave_sum(float v) {
#pragma unroll
    for (int o = 1; o < 64; o <<= 1) v += __shfl_xor(v, o);
    return v;
}
__device__ __forceinline__ int mod_row(int row) { return row < ML ? (row >> 12) : 4; }

__device__ __forceinline__ void p0_transpose_item(const float* W, int K, int N, bf16* WT, int row_off, LAS float* scr, int item, int lane) {
    const int nblk = N / 32, kb = item / nblk, nb = item % nblk, k0 = 64 * kb, n0 = 32 * nb;
#pragma unroll 8
    for (int i = 0; i < 32; ++i) { const int kk = 2 * i + (lane >> 5); scr[kk * 33 + (lane & 31)] = W[(size_t)(k0 + kk) * N + n0 + (lane & 31)]; }
    LDS_WAIT(); asm volatile("" ::: "memory");
    const int c = lane & 7;
#pragma unroll
    for (int j = 0; j < 4; ++j) { const int n = (lane >> 3) + 8 * j; const LAS float* s = scr + (8 * c) * 33 + n;
        v4u o; o.x = pk2(s[0 * 33], s[1 * 33]); o.y = pk2(s[2 * 33], s[3 * 33]); o.z = pk2(s[4 * 33], s[5 * 33]); o.w = pk2(s[6 * 33], s[7 * 33]);
        *(GAS v4u*)(WT + (size_t)(row_off + n0 + n) * K + k0 + 8 * c) = o; }
    LDS_WAIT(); asm volatile("" ::: "memory");
}
__device__ __forceinline__ void p0_transposes(Frame& F) {
    LAS float* scr = (LAS float*)(F.lds + F.wave * 16384);
    const int gw = F.vcu * NWAVES + F.wave, NGW = F.G * NWAVES;
    constexpr int I_SQ = (D / 64) * (D / 32);
    constexpr int I_G = (256 / 64) * (256 / 32);
    constexpr int I_QKV = (D / 64) * (NQKV / 32);
    constexpr int I_1 = (D / 64) * (FF / 32), I_2 = (FF / 64) * (D / 32);
    constexpr int NITEMS = I_SQ + 4 * I_G + I_SQ + I_QKV + I_SQ + 2 * I_1 + 2 * I_2;
    bf16* ws16 = (bf16*)F.ws;
    for (int it = gw; it < NITEMS; it += NGW) {
        int r = it;
        if (r < I_SQ) { p0_transpose_item(F.in[I_PWIN], D, D, (bf16*)(F.ws + WS_WIN), 0, scr, r, F.lane); continue; } r -= I_SQ;
        if (r < 4 * I_G) { const int g = r / I_G; p0_transpose_item(F.in[I_PWGRP] + (size_t)g * 65536, 256, 256, (bf16*)(F.ws + WS_WGRP) + (size_t)g * 65536, 0, scr, r % I_G, F.lane); continue; } r -= 4 * I_G;
        if (r < I_SQ) { p0_transpose_item(F.in[I_PWOUT], D, D, (bf16*)(F.ws + WS_WOUT), 0, scr, r, F.lane); continue; } r -= I_SQ;
        if (r < I_QKV) { p0_transpose_item(F.in[I_WQKV], D, NQKV, (bf16*)(F.ws + WS_WQKV), 0, scr, r, F.lane); continue; } r -= I_QKV;
        if (r < I_SQ) { p0_transpose_item(F.in[I_WO], D, D, (bf16*)(F.ws + WS_WO), 0, scr, r, F.lane); continue; } r -= I_SQ;
        if (r < 2 * I_1) { const int l = r / I_1; p0_transpose_item(F.in[I_W1] + (size_t)l * D * FF, D, FF, (bf16*)(F.ws + WS_W1) + (size_t)l * D * FF, 0, scr, r % I_1, F.lane); continue; } r -= 2 * I_1;
        { const int l = r / I_2; p0_transpose_item(F.in[I_W2] + (size_t)l * D * FF, FF, D, (bf16*)(F.ws + WS_W2) + (size_t)l * D * FF, 0, scr, r % I_2, F.lane); }
    }
    (void)ws16;
}
__device__ __forceinline__ void p0_mod(Frame& F) {
    LAS float* S = (LAS float*)F.lds;
    LAS float* P = (LAS float*)(F.lds + 20480);
    for (int i = F.tid; i < 5 * 1024; i += 512) { const int r = i >> 10, k = i & 1023; const float v = (r < 4) ? F.in[I_C][r * 1024 + k] : F.in[I_CCTX][k]; S[i] = v / (1.f + __expf(-v)); }
    __syncthreads();
    float* MOD = (float*)(F.ws + WS_MOD);
    for (int item = blockIdx.x; item < 256; item += F.G) {
        const int l = item >> 7, n0 = (item & 127) * 48;
        const float* W = F.in[I_ADAW] + (size_t)l * D * (NMOD * D);
        float acc[5] = {0.f, 0.f, 0.f, 0.f, 0.f};
        if (F.lane < 48) {
            const int k0 = F.wave * 128;
#pragma unroll 8
            for (int k = 0; k < 128; ++k) { const float w = W[(size_t)(k0 + k) * (NMOD * D) + n0 + F.lane];
#pragma unroll
                for (int r = 0; r < 5; ++r) acc[r] += S[r * 1024 + k0 + k] * w; }
#pragma unroll
            for (int r = 0; r < 5; ++r) P[(F.wave * 5 + r) * 48 + F.lane] = acc[r];
        }
        __syncthreads();
        if (F.tid < 240) { const int r = F.tid / 48, c = F.tid % 48; float s = F.in[I_ADAB][l * (NMOD * D) + n0 + c];
#pragma unroll
            for (int w = 0; w < 8; ++w) s += P[(w * 5 + r) * 48 + c];
            MOD[((size_t)l * 5 + r) * (NMOD * D) + n0 + c] = s; }
        __syncthreads();
    }
}
__device__ __forceinline__ void p0_rope_table(Frame& F) {
    const int g = blockIdx.x * 512 + F.tid;
    if (g < 1024) { const int pos = g >> 4, i = g & 15; const float inv = powf(10000.0f, -(float)(2 * i) / 32.0f); const float a = (float)pos * inv;
        float* T = (float*)(F.ws + WS_ROPE); T[2 * g] = cosf(a); T[2 * g + 1] = sinf(a); }
}
__device__ __forceinline__ void norm_mod_pass(Frame& F, const float* src_lat, const float* src_ctx, int nrows, const float* gvec, const float* modl, int ch_shift, int ch_scale, bf16* dst) {
    const int gw = F.vcu * NWAVES + F.wave, NGW = F.G * NWAVES;
    for (int row = gw; row < nrows; row += NGW) {
        const float* xrow = row < ML ? src_lat + (size_t)row * D : src_ctx + (size_t)(row - ML) * D;
        const f32x4* xr = (const f32x4*)xrow + F.lane;
        f32x4 v[4]; float s2 = 0.f;
#pragma unroll
        for (int j = 0; j < 4; ++j) { v[j] = xr[64 * j]; s2 += (v[j].x * v[j].x + v[j].y * v[j].y) + (v[j].z * v[j].z + v[j].w * v[j].w); }
        const float rstd = 1.0f / sqrtf(wave_sum(s2) * (1.f / D) + EPS);
        const float* mr = modl + (size_t)mod_row(row) * (NMOD * D);
        unsigned long long* o8 = (unsigned long long*)(dst + (size_t)row * D) + F.lane;
#pragma unroll
        for (int j = 0; j < 4; ++j) { const int c = 4 * F.lane + 256 * j;
            const f32x4 g = *(const f32x4*)(gvec + c), sh = *(const f32x4*)(mr + ch_shift * D + c), sc = *(const f32x4*)(mr + ch_scale * D + c);
            const f32x4 y = v[j] * rstd * g * (sc + 1.0f) + sh;
            o8[64 * j] = (unsigned long long)pk2(y.x, y.y) | ((unsigned long long)pk2(y.z, y.w) << 32); }
    }
}
__device__ __forceinline__ void final_norm_pass(Frame& F, float* xio, const float* gvec) {
    const int gw = F.vcu * NWAVES + F.wave, NGW = F.G * NWAVES;
    for (int row = gw; row < ML; row += NGW) {
        f32x4* xr = (f32x4*)(xio + (size_t)row * D) + F.lane;
        f32x4 v[4]; float s2 = 0.f;
#pragma unroll
        for (int j = 0; j < 4; ++j) { v[j] = xr[64 * j]; s2 += (v[j].x * v[j].x + v[j].y * v[j].y) + (v[j].z * v[j].z + v[j].w * v[j].w); }
        const float rstd = 1.0f / sqrtf(wave_sum(s2) * (1.f / D) + EPS);
#pragma unroll
        for (int j = 0; j < 4; ++j) { const f32x4 g = *(const f32x4*)(gvec + 4 * F.lane + 256 * j); xr[64 * j] = v[j] * rstd * g; }
    }
}
__device__ __forceinline__ void pool_pass(Frame& F, const bf16* U, bf16* DP) {
    const int NT = F.G * 512;
    for (int idx = blockIdx.x * 512 + F.tid; idx < MA * 128; idx += NT) {
        const int row = idx >> 7, c8 = (idx & 127) * 8, grp = c8 >> 8, hw = 1 << grp;
        int t, L; if (row < ML) { t = row & (SEQ - 1); L = SEQ; } else { t = (row - ML) & (CTXL - 1); L = CTXL; }
        const int base = row - t;
        const int lo = (t - hw) < 0 ? 0 : (t - hw), hi = (t + hw) > L ? L : (t + hw);
        float s[8] = {0.f, 0.f, 0.f, 0.f, 0.f, 0.f, 0.f, 0.f};
        for (int j = lo; j < hi; ++j) { const v4u w = *(const v4u*)(U + (size_t)(base + j) * D + c8);
            s[0] += bf2f(w.x & 0xffff); s[1] += bf2f(w.x >> 16); s[2] += bf2f(w.y & 0xffff); s[3] += bf2f(w.y >> 16);
            s[4] += bf2f(w.z & 0xffff); s[5] += bf2f(w.z >> 16); s[6] += bf2f(w.w & 0xffff); s[7] += bf2f(w.w >> 16); }
        const float inv = 1.0f / (float)(hi - lo);
        const v4u w = *(const v4u*)(U + (size_t)row * D + c8);
        v4u o;
        o.x = pk2(s[0] * inv - bf2f(w.x & 0xffff), s[1] * inv - bf2f(w.x >> 16));
        o.y = pk2(s[2] * inv - bf2f(w.y & 0xffff), s[3] * inv - bf2f(w.y >> 16));
        o.z = pk2(s[4] * inv - bf2f(w.z & 0xffff), s[5] * inv - bf2f(w.z >> 16));
        o.w = pk2(s[6] * inv - bf2f(w.w & 0xffff), s[7] * inv - bf2f(w.w >> 16));
        *(v4u*)(DP + (size_t)row * D + c8) = o;
    }
}

template <class Epi>
__device__ __forceinline__ void naive_gemm(Frame& F, const bf16* A, int lda, const bf16* Bt, int ldb, int M, int N, int K, const Epi& E) {
    LAS float* As = (LAS float*)F.lds; LAS float* Bs = As + 128 * 33;
    const int tid = F.tid, ty = tid >> 4, tx = tid & 15;
    const int ntn = N / 128, ntiles = (M / 128) * ntn;
    for (int t = blockIdx.x; t < ntiles; t += F.G) {
        const int tm = t / ntn, tn = t % ntn;
        float acc[4][8];
#pragma unroll
        for (int i = 0; i < 4; ++i)
#pragma unroll
            for (int j = 0; j < 8; ++j) acc[i][j] = 0.f;
        for (int k0 = 0; k0 < K; k0 += 32) {
            { const int r = tid >> 2, c = (tid & 3) * 8;
              const v4u a = *(const v4u*)(A + (size_t)(tm * 128 + r) * lda + k0 + c);
              const v4u b = *(const v4u*)(Bt + (size_t)(tn * 128 + r) * ldb + k0 + c);
              LAS float* ap = As + r * 33 + c; LAS float* bp = Bs + r * 33 + c;
              ap[0] = bf2f(a.x & 0xffff); ap[1] = bf2f(a.x >> 16); ap[2] = bf2f(a.y & 0xffff); ap[3] = bf2f(a.y >> 16);
              ap[4] = bf2f(a.z & 0xffff); ap[5] = bf2f(a.z >> 16); ap[6] = bf2f(a.w & 0xffff); ap[7] = bf2f(a.w >> 16);
              bp[0] = bf2f(b.x & 0xffff); bp[1] = bf2f(b.x >> 16); bp[2] = bf2f(b.y & 0xffff); bp[3] = bf2f(b.y >> 16);
              bp[4] = bf2f(b.z & 0xffff); bp[5] = bf2f(b.z >> 16); bp[6] = bf2f(b.w & 0xffff); bp[7] = bf2f(b.w >> 16); }
            __syncthreads();
#pragma unroll 4
            for (int kk = 0; kk < 32; ++kk) {
                float a[4], b[8];
#pragma unroll
                for (int i = 0; i < 4; ++i) a[i] = As[(ty * 4 + i) * 33 + kk];
#pragma unroll
                for (int j = 0; j < 8; ++j) b[j] = Bs[(tx + 16 * j) * 33 + kk];
#pragma unroll
                for (int i = 0; i < 4; ++i)
#pragma unroll
                    for (int j = 0; j < 8; ++j) acc[i][j] += a[i] * b[j];
            }
            __syncthreads();
        }
#pragma unroll
        for (int i = 0; i < 4; ++i)
#pragma unroll
            for (int j = 0; j < 8; ++j) E(tm * 128 + ty * 4 + i, tn * 128 + tx + 16 * j, acc[i][j]);
    }
}
struct NEpiBf16 { bf16* O; int ldc; int coff; const float* cscale;
    __device__ __forceinline__ void operator()(int row, int col, float v) const { const float s = cscale ? cscale[coff + col] : 1.f; O[(size_t)row * ldc + coff + col] = (bf16)f2bf(v * s); } };
struct NEpiSqRelu { bf16* O; int ldc;
    __device__ __forceinline__ void operator()(int row, int col, float v) const { const float r = v > 0.f ? v : 0.f; O[(size_t)row * ldc + col] = (bf16)f2bf(r * r); } };
struct NEpiRes { const float* src_lat; const float* src_ctx; float* dst_lat; float* dst_ctx; const float* gate;
    __device__ __forceinline__ void operator()(int row, int col, float v) const {
        const float g = gate[(size_t)mod_row(row) * (NMOD * D) + col];
        if (row < ML) dst_lat[(size_t)row * D + col] = src_lat[(size_t)row * D + col] + g * v;
        else dst_ctx[(size_t)(row - ML) * D + col] = src_ctx[(size_t)(row - ML) * D + col] + g * v; } };
struct NEpiQkvLat { float* RAW; bf16* V;
    __device__ __forceinline__ void operator()(int row, int col, float v) const { if (col < 1152) RAW[(size_t)row * 1152 + col] = v; else V[(size_t)row * KVD + col - 1152] = (bf16)f2bf(v); } };
struct NEpiKvCtx { bf16* KC; bf16* VC;
    __device__ __forceinline__ void operator()(int row, int col, float v) const { if (col < 128) KC[(size_t)row * KVD + col] = (bf16)f2bf(v); else VC[(size_t)row * KVD + col - 128] = (bf16)f2bf(v); } };

__device__ __forceinline__ void naive_rope_pass(Frame& F, const float* RAW, bf16* Q, bf16* K) {
    const float* T = (const float*)(F.ws + WS_ROPE);
    const int NT = F.G * 512;
    for (int idx = blockIdx.x * 512 + F.tid; idx < ML * 18 * 32; idx += NT) {
        const int j = idx & 31, hs = (idx >> 5) % 18, row = idx / (18 * 32);
        const int t = row & (SEQ - 1), ax = j >> 4, i = j & 15, pos = ax ? (t & 63) : (t >> 6);
        const float c = T[2 * (pos * 16 + i)], s = T[2 * (pos * 16 + i) + 1];
        const int d1 = ax * 32 + i, d2 = d1 + 16;
        const float u1 = RAW[(size_t)row * 1152 + hs * 64 + d1], u2 = RAW[(size_t)row * 1152 + hs * 64 + d2];
        const float o1 = u1 * c - u2 * s, o2 = u1 * s + u2 * c;
        if (hs < 16) { Q[(size_t)row * QDIM + hs * 64 + d1] = (bf16)f2bf(o1 * QS); Q[(size_t)row * QDIM + hs * 64 + d2] = (bf16)f2bf(o2 * QS); }
        else { K[(size_t)row * KVD + (hs - 16) * 64 + d1] = (bf16)f2bf(o1); K[(size_t)row * KVD + (hs - 16) * 64 + d2] = (bf16)f2bf(o2); }
    }
}
__device__ __forceinline__ float dot64(const float (&q)[64], const bf16* kp) {
    float s = 0.f;
#pragma unroll
    for (int c = 0; c < 8; ++c) { const v4u w = *(const v4u*)(kp + 8 * c);
        s += q[8 * c + 0] * bf2f(w.x & 0xffff) + q[8 * c + 1] * bf2f(w.x >> 16) + q[8 * c + 2] * bf2f(w.y & 0xffff) + q[8 * c + 3] * bf2f(w.y >> 16)
           + q[8 * c + 4] * bf2f(w.z & 0xffff) + q[8 * c + 5] * bf2f(w.z >> 16) + q[8 * c + 6] * bf2f(w.w & 0xffff) + q[8 * c + 7] * bf2f(w.w >> 16); }
    return s;
}
__device__ __forceinline__ void naive_attention(Frame& F, const bf16* Q, const bf16* K, const bf16* V, const bf16* KC, const bf16* VC, bf16* O) {
    const int NT = F.G * 512;
    for (int idx = blockIdx.x * 512 + F.tid; idx < NH * ML; idx += NT) {
        const int h = idx / ML, row = idx % ML, b = row >> 12, t = row & (SEQ - 1), g = h >> 3;
        float q[64];
#pragma unroll
        for (int c = 0; c < 8; ++c) { const v4u w = *(const v4u*)(Q + (size_t)row * QDIM + h * 64 + 8 * c);
            q[8 * c + 0] = bf2f(w.x & 0xffff); q[8 * c + 1] = bf2f(w.x >> 16); q[8 * c + 2] = bf2f(w.y & 0xffff); q[8 * c + 3] = bf2f(w.y >> 16);
            q[8 * c + 4] = bf2f(w.z & 0xffff); q[8 * c + 5] = bf2f(w.z >> 16); q[8 * c + 6] = bf2f(w.w & 0xffff); q[8 * c + 7] = bf2f(w.w >> 16); }
        const float sink2 = F.in[I_SINK][h] * LOG2E;
        const int jlo = (t - 128) < 0 ? 0 : (t - 128), jhi = (t + 128) > (SEQ - 1) ? (SEQ - 1) : (t + 128);
        float m = sink2;
        for (int j = jlo; j <= jhi; ++j) m = fmaxf(m, dot64(q, K + (size_t)(b * SEQ + j) * KVD + g * 64));
        for (int c = 0; c < CTXL; ++c) m = fmaxf(m, dot64(q, KC + (size_t)(b * CTXL + c) * KVD + g * 64));
        float l = exp2f(sink2 - m);
        float o[64];
#pragma unroll
        for (int d = 0; d < 64; ++d) o[d] = 0.f;
        for (int pass = 0; pass < 2; ++pass) {
            const int n = pass ? CTXL : (jhi - jlo + 1);
            const bf16* kb = pass ? KC + (size_t)(b * CTXL) * KVD + g * 64 : K + (size_t)(b * SEQ + jlo) * KVD + g * 64;
            const bf16* vb = pass ? VC + (size_t)(b * CTXL) * KVD + g * 64 : V + (size_t)(b * SEQ + jlo) * KVD + g * 64;
            for (int j = 0; j < n; ++j) {
                const float p = exp2f(dot64(q, kb + (size_t)j * KVD) - m); l += p;
#pragma unroll
                for (int c = 0; c < 8; ++c) { const v4u w = *(const v4u*)(vb + (size_t)j * KVD + 8 * c);
                    o[8 * c + 0] += p * bf2f(w.x & 0xffff); o[8 * c + 1] += p * bf2f(w.x >> 16); o[8 * c + 2] += p * bf2f(w.y & 0xffff); o[8 * c + 3] += p * bf2f(w.y >> 16);
                    o[8 * c + 4] += p * bf2f(w.z & 0xffff); o[8 * c + 5] += p * bf2f(w.z >> 16); o[8 * c + 6] += p * bf2f(w.w & 0xffff); o[8 * c + 7] += p * bf2f(w.w >> 16); }
            }
        }
        const float rl = 1.0f / l;
#pragma unroll
        for (int c = 0; c < 8; ++c) { v4u w; w.x = pk2(o[8 * c] * rl, o[8 * c + 1] * rl); w.y = pk2(o[8 * c + 2] * rl, o[8 * c + 3] * rl); w.z = pk2(o[8 * c + 4] * rl, o[8 * c + 5] * rl); w.w = pk2(o[8 * c + 6] * rl, o[8 * c + 7] * rl);
            *(v4u*)(O + (size_t)row * QDIM + h * 64 + 8 * c) = w; }
    }
}

struct Params { const float* in[18]; float* out; unsigned char* ws; };
__global__ void __launch_bounds__(NWAVES * 64, 2) fwd_kernel(Params prm) {
    extern __shared__ __attribute__((aligned(16))) unsigned char lds[];
    Frame F;
    F.lds = (LAS unsigned char*)lds;
    F.MISC = (volatile LAS unsigned*)(F.lds + MISC_OFF);
    F.tid = threadIdx.x; F.lane = F.tid & 63; F.wave = __builtin_amdgcn_readfirstlane(F.tid >> 6);
    F.G = gridDim.x; { const int bx = blockIdx.x; F.vcu = (F.G % 8 == 0) ? (bx % 8) * (F.G / 8) + bx / 8 : bx; }
    F.ws = prm.ws; F.out = prm.out;
#pragma unroll
    for (int i = 0; i < 18; ++i) F.in[i] = prm.in[i];
    F.ctl = (gu32*)(F.ws + WS_CTL);
    for (int u = F.tid; u < (LDS_BYTES - LDSCTL_OFF) / 4; u += NWAVES * 64) ((LAS unsigned*)(F.lds + LDSCTL_OFF))[u] = 0u;
    __syncthreads();
    XcdBarrier bar = xcd_barrier_post((unsigned*)(F.ctl + CW_BAR), F.MISC + 8);
#define GRID_BAR() xcd_barrier(bar)
    unsigned char* ws = F.ws;
    float* MOD = (float*)(ws + WS_MOD);
    float* CX = (float*)(ws + WS_CX);
    bf16* XN = (bf16*)(ws + WS_XN);
    bf16 *U = (bf16*)(ws + WS_U), *DP = (bf16*)(ws + WS_DP), *Y1 = (bf16*)(ws + WS_Y1), *H = (bf16*)(ws + WS_H);
    bf16 *Qb = (bf16*)(ws + WS_Q), *Kb = (bf16*)(ws + WS_K), *Vb = (bf16*)(ws + WS_V), *KC = (bf16*)(ws + WS_KC), *VC = (bf16*)(ws + WS_VC), *Ob = (bf16*)(ws + WS_O);
    float* RAW = (float*)(ws + WS_RAW);
    const bf16 *Win_t = (const bf16*)(ws + WS_WIN), *Wgrp_t = (const bf16*)(ws + WS_WGRP), *Wout_t = (const bf16*)(ws + WS_WOUT), *Wqkv_t = (const bf16*)(ws + WS_WQKV), *Wo_t = (const bf16*)(ws + WS_WO);
    const bf16 *W1_t = (const bf16*)(ws + WS_W1), *W2_t = (const bf16*)(ws + WS_W2);
    const float* MOD0 = MOD; const float* MOD1 = MOD + 5 * NMOD * D;

    p0_mod(F); p0_rope_table(F); p0_transposes(F);
    GRID_BAR();
    norm_mod_pass(F, F.in[I_X], F.in[I_CTX], MA, F.in[I_NMIXG], MOD0, 0, 1, XN);
    GRID_BAR();
    naive_gemm(F, XN, D, Win_t, D, MA, D, D, NEpiBf16{U, D, 0, nullptr});
    GRID_BAR();
    pool_pass(F, U, DP);
    GRID_BAR();
    for (int g = 0; g < 4; ++g) naive_gemm(F, DP + g * 256, D, Wgrp_t + (size_t)g * 65536, 256, MA, 256, 256, NEpiBf16{Y1, D, g * 256, F.in[I_PSCALE]});
    GRID_BAR();
    naive_gemm(F, Y1, D, Wout_t, D, MA, D, D, NEpiRes{F.in[I_X], F.in[I_CTX], F.out, CX, MOD0 + 2 * D});
    GRID_BAR();
    norm_mod_pass(F, F.out, CX, MA, F.in[I_NMLPG], MOD0, 3, 4, XN);
    GRID_BAR();
    naive_gemm(F, XN, D, W1_t, D, MA, FF, D, NEpiSqRelu{H, FF});
    GRID_BAR();
    naive_gemm(F, H, FF, W2_t, FF, MA, D, FF, NEpiRes{F.out, CX, F.out, CX, MOD0 + 5 * D});
    GRID_BAR();
    norm_mod_pass(F, F.out, CX, MA, F.in[I_NMIXG] + D, MOD1, 0, 1, XN);
    GRID_BAR();
    naive_gemm(F, XN, D, Wqkv_t, D, ML, NQKV, D, NEpiQkvLat{RAW, Vb});
    naive_gemm(F, XN + (size_t)ML * D, D, Wqkv_t + (size_t)QDIM * D, D, MC, 256, D, NEpiKvCtx{KC, VC});
    GRID_BAR();
    naive_rope_pass(F, RAW, Qb, Kb);
    GRID_BAR();
    naive_attention(F, Qb, Kb, Vb, KC, VC, Ob);
    GRID_BAR();
    naive_gemm(F, Ob, D, Wo_t, D, ML, D, D, NEpiRes{F.out, CX, F.out, CX, MOD1 + 2 * D});
    GRID_BAR();
    norm_mod_pass(F, F.out, CX, ML, F.in[I_NMLPG] + D, MOD1, 3, 4, XN);
    GRID_BAR();
    naive_gemm(F, XN, D, W1_t + (size_t)D * FF, D, ML, FF, D, NEpiSqRelu{H, FF});
    GRID_BAR();
    naive_gemm(F, H, FF, W2_t + (size_t)D * FF, FF, ML, D, FF, NEpiRes{F.out, CX, F.out, CX, MOD1 + 5 * D});
    GRID_BAR();
    final_norm_pass(F, F.out, F.in[I_FING]);
}

extern "C" void kernel_launch(void* const* d_in, const int* in_sizes, int n_in, void* d_out, int out_size, void* d_ws, size_t ws_size, hipStream_t stream) {
    static int grid = 0;
    if (grid == 0) {
        if (n_in != 18 || in_sizes[0] != ML * D || out_size != ML * D || ws_size < WS_END) { fprintf(stderr, "kernel_launch: unexpected problem shape (n_in %d, in0 %d, out %d, ws %zu); nothing launched\n", n_in, n_in > 0 ? in_sizes[0] : -1, out_size, ws_size); grid = -1; return; }
        int dev = 0, cus = 0;
        if (hipGetDevice(&dev) != hipSuccess || hipDeviceGetAttribute(&cus, hipDeviceAttributeMultiprocessorCount, dev) != hipSuccess) { fprintf(stderr, "kernel_launch: device query failed\n"); grid = -1; return; }
        if (hipFuncSetAttribute((const void*)fwd_kernel, hipFuncAttributeMaxDynamicSharedMemorySize, LDS_BYTES) != hipSuccess) { fprintf(stderr, "kernel_launch: hipFuncSetAttribute failed\n"); grid = -1; return; }
        int per_cu = 0;
        if (hipOccupancyMaxActiveBlocksPerMultiprocessor(&per_cu, (const void*)fwd_kernel, NWAVES * 64, LDS_BYTES) != hipSuccess || per_cu < 1) fprintf(stderr, "kernel_launch: note: occupancy query reports %d workgroups per CU\n", per_cu);
        (void)hipGetLastError();
        grid = cus;
    }
    if (grid < 0) return;
    if (hipMemsetAsync((char*)d_ws + WS_CTL, 0, CTL_ZERO_BYTES, stream) != hipSuccess) { fprintf(stderr, "kernel_launch: memset failed\n"); return; }
    Params a{};
    for (int i = 0; i < 18; ++i) a.in[i] = (const float*)d_in[i];
    a.out = (float*)d_out; a.ws = (unsigned char*)d_ws;
    hipLaunchKernelGGL(fwd_kernel, dim3(grid), dim3(NWAVES * 64), LDS_BYTES, stream, a);
    const hipError_t le = hipPeekAtLastError();
    if (le != hipSuccess) fprintf(stderr, "kernel_launch: launch failed: %s\n", hipGetErrorName(le));
}
```

```cpp
#include <hip/hip_runtime.h>
#include <cstdio>
#include <cstdint>

constexpr int D = 1024, BATCH = 4, SEQ = 4096, CTXL = 256, FF = 4096, NMOD = 6;
constexpr int ML = BATCH * SEQ;
constexpr int MC = BATCH * CTXL;
constexpr int MA = ML + MC;
constexpr int NQKV = 1280, QDIM = 1024, KVD = 128, HD = 64, NH = 16, NKV = 2;
constexpr float EPS = 1e-6f;
constexpr float QS = 0.125f * 1.4426950408889634f;
constexpr float LOG2E = 1.4426950408889634f;
constexpr int NWAVES = 8;

constexpr size_t MiB = 1u << 20;
constexpr size_t WS_CTL = 0, CTL_ZERO_BYTES = 1 * MiB;
constexpr size_t WS_MOD = 1 * MiB;
constexpr size_t WS_ROPE = 1 * MiB + 512 * 1024;
constexpr size_t WS_WIN = 2 * MiB, WS_WGRP = 4 * MiB, WS_WOUT = 5 * MiB, WS_WQKV = 7 * MiB, WS_WO = 10 * MiB;
constexpr size_t WS_W1 = 12 * MiB  , WS_W2 = 28 * MiB  ;
constexpr size_t WS_CX = 44 * MiB;
constexpr size_t WS_XN = 48 * MiB;
constexpr size_t WS_R = 82 * MiB;
constexpr size_t WS_U = WS_R, WS_DP = WS_R + 34 * MiB, WS_Y1 = WS_R + 68 * MiB;
constexpr size_t WS_H = WS_R;
constexpr size_t WS_Q = WS_R, WS_K = WS_R + 32 * MiB, WS_V = WS_R + 36 * MiB, WS_KC = WS_R + 40 * MiB, WS_VC = WS_KC + 256 * 1024, WS_O = WS_R + 42 * MiB;
constexpr size_t WS_RAW = 160 * MiB;
constexpr size_t WS_END = 256 * MiB;
constexpr int CW_BAR = 4096;

constexpr int RING_BYTES = 131072;
constexpr int LDSCTL_OFF = RING_BYTES, MISC_OFF = LDSCTL_OFF + 320;
constexpr int LDS_BYTES = 147456;

#define GAS __attribute__((address_space(1)))
#define LAS __attribute__((address_space(3)))
typedef unsigned short bf16;
typedef unsigned v4u __attribute__((ext_vector_type(4)));
typedef unsigned v2u __attribute__((ext_vector_type(2)));
typedef float f32x4 __attribute__((ext_vector_type(4)));
typedef short bf16x8 __attribute__((ext_vector_type(8)));
typedef GAS unsigned gu32;
#define RLX_AGENT __ATOMIC_RELAXED, __HIP_MEMORY_SCOPE_AGENT
#define LDS_WAIT() asm volatile("s_waitcnt lgkmcnt(0)" ::: "memory")
#define VM_WAIT() asm volatile("s_waitcnt vmcnt(0)" ::: "memory")
__device__ __forceinline__ unsigned f2bf(float f) { unsigned u = __builtin_bit_cast(unsigned, f); return (u + 0x7fffu + ((u >> 16) & 1u)) >> 16; }
__device__ __forceinline__ unsigned pk2(float lo, float hi) { return f2bf(lo) | (f2bf(hi) << 16); }
__device__ __forceinline__ float bf2f(unsigned short b) { return __builtin_bit_cast(float, (unsigned)b << 16); }

#define XB_TMO      128
#define XB_XCNT(j)  (256  + 64 * (j))
#define XB_XSUB(j)  (1280 + 64 * (j))
#define XB_XGEN(j)  (2304 + 64 * (j))
#define XB_TOP      3328
#define XB_TOPGEN   3392
#define XCD_BAR_WORDS 3456
#define XB_SPIN_CAP (1u << 18)

__device__ __forceinline__ unsigned xb_ld(unsigned* p)              { return __hip_atomic_load(p, __ATOMIC_RELAXED, __HIP_MEMORY_SCOPE_AGENT); }
__device__ __forceinline__ unsigned xb_add(unsigned* p, unsigned v) { return __hip_atomic_fetch_add(p, v, __ATOMIC_RELAXED, __HIP_MEMORY_SCOPE_AGENT); }
__device__ __forceinline__ unsigned xb_xcc_id() { return (unsigned)__builtin_amdgcn_s_getreg((3 << 11) | 20) & 0xFu; }
#define XB_SPIN(cond, bar) do { unsigned _sp = 0; while (cond) { __builtin_amdgcn_s_sleep(1); \
    if ((++_sp & 255u) == 0u) { if (xb_ld(&(bar)[XB_TMO])) break; if (_sp > XB_SPIN_CAP) { atomicAdd(&(bar)[XB_TMO], 1u); break; } } } } while (0)

struct XcdBarrier {
    unsigned* bar; unsigned x;
    volatile LAS unsigned* st;
};

__device__ __forceinline__ XcdBarrier xcd_barrier_post(unsigned* bar, volatile LAS unsigned* st) {
    XcdBarrier b; b.bar = bar; b.x = xb_xcc_id(); b.st = st;
    if (threadIdx.x == 0) (void)xb_add(&bar[XB_XCNT(b.x)], 1u);
    return b;
}
__device__ __forceinline__ void xcd_barrier_complete(unsigned* bar, unsigned x, unsigned& nloc, unsigned& nx) {
    const unsigned G = gridDim.x * gridDim.y * gridDim.z;
    unsigned sum, cnt, mine, sp = 0u;
    for (;;) {
        sum = 0u; cnt = 0u; mine = 0u;
#pragma unroll
        for (unsigned j = 0; j < 16; ++j) { const unsigned c = xb_ld(&bar[XB_XCNT(j)]); sum += c; cnt += (c > 0u) ? 1u : 0u; mine = (j == x) ? c : mine; }
        if (sum == G) break;
        __builtin_amdgcn_s_sleep(1);
        if ((++sp & 255u) == 0u) { if (xb_ld(&bar[XB_TMO])) break; if (sp > XB_SPIN_CAP) { atomicAdd(&bar[XB_TMO], 1u); break; } }
    }
    nloc = mine > 0u ? mine : 1u; nx = cnt > 0u ? cnt : 1u;
}

__device__ __forceinline__ void xcd_barrier(const XcdBarrier& b) {
    asm volatile("s_waitcnt vmcnt(0)" ::: "memory");
    __syncthreads();
    if (threadIdx.x == 0) {
        unsigned* bar = b.bar;
        __builtin_amdgcn_s_waitcnt(0);
        unsigned nloc = b.st[0], nx = b.st[1];
        if (nloc == 0u) { xcd_barrier_complete(bar, b.x, nloc, nx); b.st[0] = nloc; b.st[1] = nx; }
        const unsigned old = xb_add(&bar[XB_XSUB(b.x)], 1u);
        const unsigned gen = old / nloc;
        if (old + 1u == (gen + 1u) * nloc) {
            __builtin_amdgcn_fence(__ATOMIC_RELEASE, "agent");
            asm volatile("s_waitcnt vmcnt(0)" ::: "memory");
            const unsigned og = xb_add(&bar[XB_TOP], 1u);
            const unsigned tg = og / nx;
            if (og + 1u == (tg + 1u) * nx) xb_add(&bar[XB_TOPGEN], 1u);
            else XB_SPIN(xb_ld(&bar[XB_TOPGEN]) == tg, bar);
            __builtin_amdgcn_fence(__ATOMIC_ACQUIRE, "agent");
            xb_add(&bar[XB_XGEN(b.x)], 1u);
            asm volatile("s_waitcnt vmcnt(0)" ::: "memory");
        } else {
            XB_SPIN(xb_ld(&bar[XB_XGEN(b.x)]) == gen, bar);
            __builtin_amdgcn_fence(__ATOMIC_ACQUIRE, "agent");
            asm volatile("s_waitcnt vmcnt(0)" ::: "memory");
        }
    }
    __syncthreads();
}

struct Frame {
    LAS unsigned char* lds;
    volatile LAS unsigned* MISC;
    gu32* ctl;
    int tid, lane, wave;
    int vcu, G;
    unsigned char* ws;
    const float* in[18];
    float* out;
};
enum { I_X = 0, I_C, I_CTX, I_CCTX, I_ADAW, I_ADAB, I_NMIXG, I_NMLPG, I_PWIN, I_PWGRP, I_PSCALE, I_PWOUT, I_WQKV, I_SINK, I_WO, I_W1, I_W2, I_FING };

__device__ __forceinline__ float wave_sum(float v) {
#pragma unroll
    for (int o = 1; o < 64; o <<= 1) v += __shfl_xor(v, o);
    return v;
}
__device__ __forceinline__ int mod_row(int row) { return row < ML ? (row >> 12) : 4; }

__device__ __forceinline__ void p0_transpose_item(const float* W, int K, int N, bf16* WT, int row_off, LAS float* scr, int item, int lane) {
    const int nblk = N / 32, kb = item / nblk, nb = item % nblk, k0 = 64 * kb, n0 = 32 * nb;
#pragma unroll 8
    for (int i = 0; i < 32; ++i) { const int kk = 2 * i + (lane >> 5); scr[kk * 33 + (lane & 31)] = W[(size_t)(k0 + kk) * N + n0 + (lane & 31)]; }
    LDS_WAIT(); asm volatile("" ::: "memory");
    const int c = lane & 7;
#pragma unroll
    for (int j = 0; j < 4; ++j) { const int n = (lane >> 3) + 8 * j; const LAS float* s = scr + (8 * c) * 33 + n;
        v4u o; o.x = pk2(s[0 * 33], s[1 * 33]); o.y = pk2(s[2 * 33], s[3 * 33]); o.z = pk2(s[4 * 33], s[5 * 33]); o.w = pk2(s[6 * 33], s[7 * 33]);
        *(GAS v4u*)(WT + (size_t)(row_off + n0 + n) * K + k0 + 8 * c) = o; }
    LDS_WAIT(); asm volatile("" ::: "memory");
}
__device__ __forceinline__ void p0_transposes(Frame& F) {
    LAS float* scr = (LAS float*)(F.lds + F.wave * 16384);
    const int gw = F.vcu * NWAVES + F.wave, NGW = F.G * NWAVES;
    constexpr int I_SQ = (D / 64) * (D / 32);
    constexpr int I_G = (256 / 64) * (256 / 32);
    constexpr int I_QKV = (D / 64) * (NQKV / 32);
    constexpr int I_1 = (D / 64) * (FF / 32), I_2 = (FF / 64) * (D / 32);
    constexpr int NITEMS = I_SQ + 4 * I_G + I_SQ + I_QKV + I_SQ + 2 * I_1 + 2 * I_2;
    bf16* ws16 = (bf16*)F.ws;
    for (int it = gw; it < NITEMS; it += NGW) {
        int r = it;
        if (r < I_SQ) { p0_transpose_item(F.in[I_PWIN], D, D, (bf16*)(F.ws + WS_WIN), 0, scr, r, F.lane); continue; } r -= I_SQ;
        if (r < 4 * I_G) { const int g = r / I_G; p0_transpose_item(F.in[I_PWGRP] + (size_t)g * 65536, 256, 256, (bf16*)(F.ws + WS_WGRP) + (size_t)g * 65536, 0, scr, r % I_G, F.lane); continue; } r -= 4 * I_G;
        if (r < I_SQ) { p0_transpose_item(F.in[I_PWOUT], D, D, (bf16*)(F.ws + WS_WOUT), 0, scr, r, F.lane); continue; } r -= I_SQ;
        if (r < I_QKV) { p0_transpose_item(F.in[I_WQKV], D, NQKV, (bf16*)(F.ws + WS_WQKV), 0, scr, r, F.lane); continue; } r -= I_QKV;
        if (r < I_SQ) { p0_transpose_item(F.in[I_WO], D, D, (bf16*)(F.ws + WS_WO), 0, scr, r, F.lane); continue; } r -= I_SQ;
        if (r < 2 * I_1) { const int l = r / I_1; p0_transpose_item(F.in[I_W1] + (size_t)l * D * FF, D, FF, (bf16*)(F.ws + WS_W1) + (size_t)l * D * FF, 0, scr, r % I_1, F.lane); continue; } r -= 2 * I_1;
        { const int l = r / I_2; p0_transpose_item(F.in[I_W2] + (size_t)l * D * FF, FF, D, (bf16*)(F.ws + WS_W2) + (size_t)l * D * FF, 0, scr, r % I_2, F.lane); }
    }
    (void)ws16;
}
__device__ __forceinline__ void p0_mod(Frame& F) {
    LAS float* S = (LAS float*)F.lds;
    LAS float* P = (LAS float*)(F.lds + 20480);
    for (int i = F.tid; i < 5 * 1024; i += 512) { const int r = i >> 10, k = i & 1023; const float v = (r < 4) ? F.in[I_C][r * 1024 + k] : F.in[I_CCTX][k]; S[i] = v / (1.f + __expf(-v)); }
    __syncthreads();
    float* MOD = (float*)(F.ws + WS_MOD);
    for (int item = blockIdx.x; item < 256; item += F.G) {
        const int l = item >> 7, n0 = (item & 127) * 48;
        const float* W = F.in[I_ADAW] + (size_t)l * D * (NMOD * D);
        float acc[5] = {0.f, 0.f, 0.f, 0.f, 0.f};
        if (F.lane < 48) {
            const int k0 = F.wave * 128;
#pragma unroll 8
            for (int k = 0; k < 128; ++k) { const float w = W[(size_t)(k0 + k) * (NMOD * D) + n0 + F.lane];
#pragma unroll
                for (int r = 0; r < 5; ++r) acc[r] += S[r * 1024 + k0 + k] * w; }
#pragma unroll
            for (int r = 0; r < 5; ++r) P[(F.wave * 5 + r) * 48 + F.lane] = acc[r];
        }
        __syncthreads();
        if (F.tid < 240) { const int r = F.tid / 48, c = F.tid % 48; float s = F.in[I_ADAB][l * (NMOD * D) + n0 + c];
#pragma unroll
            for (int w = 0; w < 8; ++w) s += P[(w * 5 + r) * 48 + c];
            MOD[((size_t)l * 5 + r) * (NMOD * D) + n0 + c] = s; }
        __syncthreads();
    }
}
__device__ __forceinline__ void p0_rope_table(Frame& F) {
    const int g = blockIdx.x * 512 + F.tid;
    if (g < 1024) { const int pos = g >> 4, i = g & 15; const float inv = powf(10000.0f, -(float)(2 * i) / 32.0f); const float a = (float)pos * inv;
        float* T = (float*)(F.ws + WS_ROPE); T[2 * g] = cosf(a); T[2 * g + 1] = sinf(a); }
}
__device__ __forceinline__ void norm_mod_pass(Frame& F, const float* src_lat, const float* src_ctx, int nrows, const float* gvec, const float* modl, int ch_shift, int ch_scale, bf16* dst) {
    const int gw = F.vcu * NWAVES + F.wave, NGW = F.G * NWAVES;
    for (int row = gw; row < nrows; row += NGW) {
        const float* xrow = row < ML ? src_lat + (size_t)row * D : src_ctx + (size_t)(row - ML) * D;
        const f32x4* xr = (const f32x4*)xrow + F.lane;
        f32x4 v[4]; float s2 = 0.f;
#pragma unroll
        for (int j = 0; j < 4; ++j) { v[j] = xr[64 * j]; s2 += (v[j].x * v[j].x + v[j].y * v[j].y) + (v[j].z * v[j].z + v[j].w * v[j].w); }
        const float rstd = 1.0f / sqrtf(wave_sum(s2) * (1.f / D) + EPS);
        const float* mr = modl + (size_t)mod_row(row) * (NMOD * D);
        unsigned long long* o8 = (unsigned long long*)(dst + (size_t)row * D) + F.lane;
#pragma unroll
        for (int j = 0; j < 4; ++j) { const int c = 4 * F.lane + 256 * j;
            const f32x4 g = *(const f32x4*)(gvec + c), sh = *(const f32x4*)(mr + ch_shift * D + c), sc = *(const f32x4*)(mr + ch_scale * D + c);
            const f32x4 y = v[j] * rstd * g * (sc + 1.0f) + sh;
            o8[64 * j] = (unsigned long long)pk2(y.x, y.y) | ((unsigned long long)pk2(y.z, y.w) << 32); }
    }
}
__device__ __forceinline__ void final_norm_pass(Frame& F, float* xio, const float* gvec) {
    const int gw = F.vcu * NWAVES + F.wave, NGW = F.G * NWAVES;
    for (int row = gw; row < ML; row += NGW) {
        f32x4* xr = (f32x4*)(xio + (size_t)row * D) + F.lane;
        f32x4 v[4]; float s2 = 0.f;
#pragma unroll
        for (int j = 0; j < 4; ++j) { v[j] = xr[64 * j]; s2 += (v[j].x * v[j].x + v[j].y * v[j].y) + (v[j].z * v[j].z + v[j].w * v[j].w); }
        const float rstd = 1.0f / sqrtf(wave_sum(s2) * (1.f / D) + EPS);
#pragma unroll
        for (int j = 0; j < 4; ++j) { const f32x4 g = *(const f32x4*)(gvec + 4 * F.lane + 256 * j); xr[64 * j] = v[j] * rstd * g; }
    }
}
__device__ __forceinline__ void pool_pass(Frame& F, const bf16* U, bf16* DP) {
    const int NT = F.G * 512;
    for (int idx = blockIdx.x * 512 + F.tid; idx < MA * 128; idx += NT) {
        const int row = idx >> 7, c8 = (idx & 127) * 8, grp = c8 >> 8, hw = 1 << grp;
        int t, L; if (row < ML) { t = row & (SEQ - 1); L = SEQ; } else { t = (row - ML) & (CTXL - 1); L = CTXL; }
        const int base = row - t;
        const int lo = (t - hw) < 0 ? 0 : (t - hw), hi = (t + hw) > L ? L : (t + hw);
        float s[8] = {0.f, 0.f, 0.f, 0.f, 0.f, 0.f, 0.f, 0.f};
        for (int j = lo; j < hi; ++j) { const v4u w = *(const v4u*)(U + (size_t)(base + j) * D + c8);
            s[0] += bf2f(w.x & 0xffff); s[1] += bf2f(w.x >> 16); s[2] += bf2f(w.y & 0xffff); s[3] += bf2f(w.y >> 16);
            s[4] += bf2f(w.z & 0xffff); s[5] += bf2f(w.z >> 16); s[6] += bf2f(w.w & 0xffff); s[7] += bf2f(w.w >> 16); }
        const float inv = 1.0f / (float)(hi - lo);
        const v4u w = *(const v4u*)(U + (size_t)row * D + c8);
        v4u o;
        o.x = pk2(s[0] * inv - bf2f(w.x & 0xffff), s[1] * inv - bf2f(w.x >> 16));
        o.y = pk2(s[2] * inv - bf2f(w.y & 0xffff), s[3] * inv - bf2f(w.y >> 16));
        o.z = pk2(s[4] * inv - bf2f(w.z & 0xffff), s[5] * inv - bf2f(w.z >> 16));
        o.w = pk2(s[6] * inv - bf2f(w.w & 0xffff), s[7] * inv - bf2f(w.w >> 16));
        *(v4u*)(DP + (size_t)row * D + c8) = o;
    }
}

template <class Epi>
__device__ __forceinline__ void naive_gemm(Frame& F, const bf16* A, int lda, const bf16* Bt, int ldb, int M, int N, int K, const Epi& E) {
    LAS float* As = (LAS float*)F.lds; LAS float* Bs = As + 128 * 33;
    const int tid = F.tid, ty = tid >> 4, tx = tid & 15;
    const int ntn = N / 128, ntiles = (M / 128) * ntn;
    for (int t = blockIdx.x; t < ntiles; t += F.G) {
        const int tm = t / ntn, tn = t % ntn;
        float acc[4][8];
#pragma unroll
        for (int i = 0; i < 4; ++i)
#pragma unroll
            for (int j = 0; j < 8; ++j) acc[i][j] = 0.f;
        for (int k0 = 0; k0 < K; k0 += 32) {
            { const int r = tid >> 2, c = (tid & 3) * 8;
              const v4u a = *(const v4u*)(A + (size_t)(tm * 128 + r) * lda + k0 + c);
              const v4u b = *(const v4u*)(Bt + (size_t)(tn * 128 + r) * ldb + k0 + c);
              LAS float* ap = As + r * 33 + c; LAS float* bp = Bs + r * 33 + c;
              ap[0] = bf2f(a.x & 0xffff); ap[1] = bf2f(a.x >> 16); ap[2] = bf2f(a.y & 0xffff); ap[3] = bf2f(a.y >> 16);
              ap[4] = bf2f(a.z & 0xffff); ap[5] = bf2f(a.z >> 16); ap[6] = bf2f(a.w & 0xffff); ap[7] = bf2f(a.w >> 16);
              bp[0] = bf2f(b.x & 0xffff); bp[1] = bf2f(b.x >> 16); bp[2] = bf2f(b.y & 0xffff); bp[3] = bf2f(b.y >> 16);
              bp[4] = bf2f(b.z & 0xffff); bp[5] = bf2f(b.z >> 16); bp[6] = bf2f(b.w & 0xffff); bp[7] = bf2f(b.w >> 16); }
            __syncthreads();
#pragma unroll 4
            for (int kk = 0; kk < 32; ++kk) {
                float a[4], b[8];
#pragma unroll
                for (int i = 0; i < 4; ++i) a[i] = As[(ty * 4 + i) * 33 + kk];
#pragma unroll
                for (int j = 0; j < 8; ++j) b[j] = Bs[(tx + 16 * j) * 33 + kk];
#pragma unroll
                for (int i = 0; i < 4; ++i)
#pragma unroll
                    for (int j = 0; j < 8; ++j) acc[i][j] += a[i] * b[j];
            }
            __syncthreads();
        }
#pragma unroll
        for (int i = 0; i < 4; ++i)
#pragma unroll
            for (int j = 0; j < 8; ++j) E(tm * 128 + ty * 4 + i, tn * 128 + tx + 16 * j, acc[i][j]);
    }
}
struct NEpiBf16 { bf16* O; int ldc; int coff; const float* cscale;
    __device__ __forceinline__ void operator()(int row, int col, float v) const { const float s = cscale ? cscale[coff + col] : 1.f; O[(size_t)row * ldc + coff + col] = (bf16)f2bf(v * s); } };
struct NEpiSqRelu { bf16* O; int ldc;
    __device__ __forceinline__ void operator()(int row, int col, float v) const { const float r = v > 0.f ? v : 0.f; O[(size_t)row * ldc + col] = (bf16)f2bf(r * r); } };
struct NEpiRes { const float* src_lat; const float* src_ctx; float* dst_lat; float* dst_ctx; const float* gate;
    __device__ __forceinline__ void operator()(int row, int col, float v) const {
        const float g = gate[(size_t)mod_row(row) * (NMOD * D) + col];
        if (row < ML) dst_lat[(size_t)row * D + col] = src_lat[(size_t)row * D + col] + g * v;
        else dst_ctx[(size_t)(row - ML) * D + col] = src_ctx[(size_t)(row - ML) * D + col] + g * v; } };
struct NEpiQkvLat { float* RAW; bf16* V;
    __device__ __forceinline__ void operator()(int row, int col, float v) const { if (col < 1152) RAW[(size_t)row * 1152 + col] = v; else V[(size_t)row * KVD + col - 1152] = (bf16)f2bf(v); } };
struct NEpiKvCtx { bf16* KC; bf16* VC;
    __device__ __forceinline__ void operator()(int row, int col, float v) const { if (col < 128) KC[(size_t)row * KVD + col] = (bf16)f2bf(v); else VC[(size_t)row * KVD + col - 128] = (bf16)f2bf(v); } };

__device__ __forceinline__ void naive_rope_pass(Frame& F, const float* RAW, bf16* Q, bf16* K) {
    const float* T = (const float*)(F.ws + WS_ROPE);
    const int NT = F.G * 512;
    for (int idx = blockIdx.x * 512 + F.tid; idx < ML * 18 * 32; idx += NT) {
        const int j = idx & 31, hs = (idx >> 5) % 18, row = idx / (18 * 32);
        const int t = row & (SEQ - 1), ax = j >> 4, i = j & 15, pos = ax ? (t & 63) : (t >> 6);
        const float c = T[2 * (pos * 16 + i)], s = T[2 * (pos * 16 + i) + 1];
        const int d1 = ax * 32 + i, d2 = d1 + 16;
        const float u1 = RAW[(size_t)row * 1152 + hs * 64 + d1], u2 = RAW[(size_t)row * 1152 + hs * 64 + d2];
        const float o1 = u1 * c - u2 * s, o2 = u1 * s + u2 * c;
        if (hs < 16) { Q[(size_t)row * QDIM + hs * 64 + d1] = (bf16)f2bf(o1 * QS); Q[(size_t)row * QDIM + hs * 64 + d2] = (bf16)f2bf(o2 * QS); }
        else { K[(size_t)row * KVD + (hs - 16) * 64 + d1] = (bf16)f2bf(o1); K[(size_t)row * KVD + (hs - 16) * 64 + d2] = (bf16)f2bf(o2); }
    }
}
__device__ __forceinline__ float dot64(const float (&q)[64], const bf16* kp) {
    float s = 0.f;
#pragma unroll
    for (int c = 0; c < 8; ++c) { const v4u w = *(const v4u*)(kp + 8 * c);
        s += q[8 * c + 0] * bf2f(w.x & 0xffff) + q[8 * c + 1] * bf2f(w.x >> 16) + q[8 * c + 2] * bf2f(w.y & 0xffff) + q[8 * c + 3] * bf2f(w.y >> 16)
           + q[8 * c + 4] * bf2f(w.z & 0xffff) + q[8 * c + 5] * bf2f(w.z >> 16) + q[8 * c + 6] * bf2f(w.w & 0xffff) + q[8 * c + 7] * bf2f(w.w >> 16); }
    return s;
}
__device__ __forceinline__ void naive_attention(Frame& F, const bf16* Q, const bf16* K, const bf16* V, const bf16* KC, const bf16* VC, bf16* O) {
    const int NT = F.G * 512;
    for (int idx = blockIdx.x * 512 + F.tid; idx < NH * ML; idx += NT) {
        const int h = idx / ML, row = idx % ML, b = row >> 12, t = row & (SEQ - 1), g = h >> 3;
        float q[64];
#pragma unroll
        for (int c = 0; c < 8; ++c) { const v4u w = *(const v4u*)(Q + (size_t)row * QDIM + h * 64 + 8 * c);
            q[8 * c + 0] = bf2f(w.x & 0xffff); q[8 * c + 1] = bf2f(w.x >> 16); q[8 * c + 2] = bf2f(w.y & 0xffff); q[8 * c + 3] = bf2f(w.y >> 16);
            q[8 * c + 4] = bf2f(w.z & 0xffff); q[8 * c + 5] = bf2f(w.z >> 16); q[8 * c + 6] = bf2f(w.w & 0xffff); q[8 * c + 7] = bf2f(w.w >> 16); }
        const float sink2 = F.in[I_SINK][h] * LOG2E;
        const int jlo = (t - 128) < 0 ? 0 : (t - 128), jhi = (t + 128) > (SEQ - 1) ? (SEQ - 1) : (t + 128);
        float m = sink2;
        for (int j = jlo; j <= jhi; ++j) m = fmaxf(m, dot64(q, K + (size_t)(b * SEQ + j) * KVD + g * 64));
        for (int c = 0; c < CTXL; ++c) m = fmaxf(m, dot64(q, KC + (size_t)(b * CTXL + c) * KVD + g * 64));
        float l = exp2f(sink2 - m);
        float o[64];
#pragma unroll
        for (int d = 0; d < 64; ++d) o[d] = 0.f;
        for (int pass = 0; pass < 2; ++pass) {
            const int n = pass ? CTXL : (jhi - jlo + 1);
            const bf16* kb = pass ? KC + (size_t)(b * CTXL) * KVD + g * 64 : K + (size_t)(b * SEQ + jlo) * KVD + g * 64;
            const bf16* vb = pass ? VC + (size_t)(b * CTXL) * KVD + g * 64 : V + (size_t)(b * SEQ + jlo) * KVD + g * 64;
            for (int j = 0; j < n; ++j) {
                const float p = exp2f(dot64(q, kb + (size_t)j * KVD) - m); l += p;
#pragma unroll
                for (int c = 0; c < 8; ++c) { const v4u w = *(const v4u*)(vb + (size_t)j * KVD + 8 * c);
                    o[8 * c + 0] += p * bf2f(w.x & 0xffff); o[8 * c + 1] += p * bf2f(w.x >> 16); o[8 * c + 2] += p * bf2f(w.y & 0xffff); o[8 * c + 3] += p * bf2f(w.y >> 16);
                    o[8 * c + 4] += p * bf2f(w.z & 0xffff); o[8 * c + 5] += p * bf2f(w.z >> 16); o[8 * c + 6] += p * bf2f(w.w & 0xffff); o[8 * c + 7] += p * bf2f(w.w >> 16); }
            }
        }
        const float rl = 1.0f / l;
#pragma unroll
        for (int c = 0; c < 8; ++c) { v4u w; w.x = pk2(o[8 * c] * rl, o[8 * c + 1] * rl); w.y = pk2(o[8 * c + 2] * rl, o[8 * c + 3] * rl); w.z = pk2(o[8 * c + 4] * rl, o[8 * c + 5] * rl); w.w = pk2(o[8 * c + 6] * rl, o[8 * c + 7] * rl);
            *(v4u*)(O + (size_t)row * QDIM + h * 64 + 8 * c) = w; }
    }
}

#ifndef FAST_GEMM
#define FAST_GEMM 1
#endif
namespace pg8 {
#define PG8_LAS __attribute__((address_space(3)))
typedef unsigned short bf16_t;
typedef short bf16x8 __attribute__((ext_vector_type(8)));
typedef float f32x4 __attribute__((ext_vector_type(4)));
typedef unsigned u32x4 __attribute__((ext_vector_type(4)));
constexpr int BM = 256, BK = 64, HALF = 128, HTB = HALF * BK * 2  , STAGE_BYTES = 8 * HTB, NXCD = 8, WGM = 8;

__host__ __device__ __forceinline__ int lds_byte(int r, int c) { const int st = (r >> 4) * 2 + (c >> 5), rr = r & 15, cc = c & 31, ob = rr * 64 + cc * 2; return st * 1024 + (ob ^ (((ob >> 9) & 1) << 5)); }
__host__ __device__ __forceinline__ void stage_rc(int b, int& R, int& C) { const int st = b / 1024, sb = b % 1024, swz = sb ^ (((sb >> 9) & 1) << 5); R = (st >> 1) * 16 + swz / 64; C = (st & 1) * 32 + (swz % 64) / 2; }
__host__ __device__ __forceinline__ int perm32(int rho) { const int n = rho >> 4, i = rho & 15; return 8 * (i >> 2) + 4 * n + (i & 3); }

struct Unit { int pm, pn; };
struct Gemm { const bf16_t* A; const bf16_t* Bt; int K, lda, ldb, a_pn_off; };

struct StaticOrder {
    int nM, nN, nwg, G, c;
    __host__ __device__ void init(int M, int N, int G_, int c_) { nM = M / BM; nN = N / BM; nwg = nM * nN; G = G_; c = c_; }
    __host__ __device__ bool next(int i, Unit& u) const {
        const long L = (long)i * G + c; if (L >= nwg) return false;
        int wgid = (int)L; { const int q = nwg / NXCD, r = nwg % NXCD, xcd = wgid % NXCD, off = wgid / NXCD; wgid = (xcd < r ? xcd * (q + 1) : r * (q + 1) + (xcd - r) * q) + off; }
        const int nig = WGM * nN, gid = wgid / nig, fm = gid * WGM, gsz = (nM - fm) < WGM ? (nM - fm) : WGM;
        u.pm = fm + ((wgid % nig) % gsz); u.pn = (wgid % nig) / gsz; return true;
    }
    __device__ __forceinline__ void a_ready(const Unit&) const {}
    __device__ __forceinline__ void done(const Unit&) const {}
};

__device__ __forceinline__ unsigned cvt_pk_bf16(float lo, float hi) { unsigned r; asm volatile("v_cvt_pk_bf16_f32 %0, %1, %2" : "=v"(r) : "v"(lo), "v"(hi)); return r; }

template <class Epi, class Sched, bool ALIGN_EPI = false, bool SP2 = false>
__device__ __forceinline__ void gemm_phase(PG8_LAS unsigned char* lds, const Gemm g, const Sched& S, const Epi& E) {
    const int tid = threadIdx.x, wid = __builtin_amdgcn_readfirstlane(tid >> 6), lane = tid & 63, wr = wid >> 2, wc = wid & 3, fr = lane & 15, fq = lane >> 4;
    const int K = g.K, nt = K / BK;
    unsigned voffA[2], voffB[2];
#pragma unroll
    for (int i = 0; i < 2; ++i) { int R, C; stage_rc(tid * 16 + i * 8192, R, C); const int Rb = Epi::PERM ? ((R & ~31) + perm32(R & 31)) : R;
        voffA[i] = (unsigned)(R * g.lda + C) * 2u; voffB[i] = (unsigned)(Rb * g.ldb + C) * 2u; }
    const size_t kstep = (size_t)(BK * 2);
    const size_t hstepA = (size_t)HALF * g.lda * 2, hstepB = (size_t)HALF * g.ldb * 2;
    const size_t tstepA = 2 * hstepA, tstepB = 2 * hstepB, pnoffA = (size_t)g.a_pn_off * 2;
    const unsigned ldsw = (unsigned)wid * 1024u;
    const int aoff = lds_byte(wr * 64 + fr, fq * 8), boff = lds_byte(wc * 32 + fr, fq * 8);
#define PG8_SA(b, h) (((b) * 2 + (h)) * HTB)
#define PG8_SB(b, h) ((4 + (b) * 2 + (h)) * HTB)
#define PG8_STAGE(bufoff, gbase, voff) do { _Pragma("unroll") for (int _i = 0; _i < 2; ++_i) \
        __builtin_amdgcn_global_load_lds((const unsigned*)((const char*)(gbase) + (voff)[_i]), (PG8_LAS unsigned*)(lds + (bufoff) + ldsw + _i * 8192), 16, 0, 0); } while (0)
#define PG8_LDA(dst, b, h) do { _Pragma("unroll") for (int m = 0; m < 4; ++m) _Pragma("unroll") for (int k = 0; k < 2; ++k) dst[m][k] = *(const PG8_LAS bf16x8*)(lds + PG8_SA(b, h) + aoff + m * 2048 + k * 1024); } while (0)
#define PG8_LDB(dst, b, h) do { _Pragma("unroll") for (int n = 0; n < 2; ++n) _Pragma("unroll") for (int k = 0; k < 2; ++k) dst[n][k] = *(const PG8_LAS bf16x8*)(lds + PG8_SB(b, h) + boff + n * 2048 + k * 1024); } while (0)
#define PG8_MMA(ai, bj, At, Bt) do { __builtin_amdgcn_s_setprio(1); _Pragma("unroll") for (int m = 0; m < 4; ++m) _Pragma("unroll") for (int n = 0; n < 2; ++n) _Pragma("unroll") for (int k = 0; k < 2; ++k) \
        acc[ai][bj][m][n] = __builtin_amdgcn_mfma_f32_16x16x32_bf16(Bt[n][k], At[m][k], acc[ai][bj][m][n], 0, 0, 0); __builtin_amdgcn_s_setprio(0); } while (0)
#define PG8_WAIT_V(n) asm volatile("s_waitcnt vmcnt(" #n ")" ::: "memory")
#define PG8_WAIT_L(n) asm volatile("s_waitcnt lgkmcnt(" #n ")" ::: "memory")
#define PG8_BAR __builtin_amdgcn_s_barrier()
#define PG8_SCHED __builtin_amdgcn_sched_barrier(0)
    Unit cur, nxt; int ui = 0;
    if (!S.next(0, cur)) return;
    f32x4 acc[2][2][4][2];
#pragma unroll
    for (int a = 0; a < 2; ++a)
#pragma unroll
        for (int b = 0; b < 2; ++b)
#pragma unroll
            for (int m = 0; m < 4; ++m)
#pragma unroll
                for (int n = 0; n < 2; ++n) acc[a][b][m][n] = (f32x4){0.f, 0.f, 0.f, 0.f};
    bf16x8 At[4][2], B0[2][2], B1[2][2];
    const char* cA = (const char*)g.A + (size_t)cur.pm * tstepA + (size_t)cur.pn * pnoffA; const char* cB = (const char*)g.Bt + (size_t)cur.pn * tstepB;
    S.a_ready(cur);
    if constexpr (SP2) {
        PG8_STAGE(PG8_SB(0, 0), cB, voffB); PG8_STAGE(PG8_SB(0, 1), cB + hstepB, voffB); PG8_STAGE(PG8_SA(0, 0), cA, voffA); PG8_STAGE(PG8_SA(0, 1), cA + hstepA, voffA);
        if (wr == 1) PG8_BAR;
        PG8_WAIT_V(2); PG8_BAR;
        PG8_STAGE(PG8_SB(1, 0), cB + kstep, voffB); PG8_STAGE(PG8_SA(1, 0), cA + kstep, voffA); PG8_STAGE(PG8_SB(1, 1), cB + hstepB + kstep, voffB);
        PG8_WAIT_V(6); PG8_BAR;
    } else {
        PG8_STAGE(PG8_SB(0, 0), cB, voffB); PG8_STAGE(PG8_SA(0, 0), cA, voffA); PG8_STAGE(PG8_SB(0, 1), cB + hstepB, voffB); PG8_STAGE(PG8_SA(0, 1), cA + hstepA, voffA);
        if (wr == 1) PG8_BAR;
        PG8_WAIT_V(4); PG8_BAR;
        PG8_STAGE(PG8_SB(1, 0), cB + kstep, voffB); PG8_STAGE(PG8_SA(1, 0), cA + kstep, voffA); PG8_STAGE(PG8_SB(1, 1), cB + hstepB + kstep, voffB);
        PG8_WAIT_V(6); PG8_BAR;
    }
    for (;;) {
        const bool has_next = S.next(ui + 1, nxt);
        const char* nA = has_next ? (const char*)g.A + (size_t)nxt.pm * tstepA + (size_t)nxt.pn * pnoffA : cA; const char* nB = has_next ? (const char*)g.Bt + (size_t)nxt.pn * tstepB : cB;
        for (int t = 0; t < nt; t += 2) {
            const bool last = (t == nt - 2);
            const char* a1 = cA + (size_t)(t + 1) * kstep;
            const char* a2 = last ? nA : cA + (size_t)(t + 2) * kstep; const char* b2 = last ? nB : cB + (size_t)(t + 2) * kstep;
            const char* a3 = a2 + kstep; const char* b3 = b2 + kstep;
            if (last && has_next) S.a_ready(nxt);
            if constexpr (SP2) {
            PG8_LDB(B0, 0, 0); PG8_LDB(B1, 0, 1); PG8_SCHED; PG8_LDA(At, 0, 0); PG8_STAGE(PG8_SA(1, 1), a1 + hstepA, voffA);
            PG8_WAIT_V(8); PG8_WAIT_L(0); PG8_BAR; PG8_MMA(0, 0, At, B0); PG8_MMA(0, 1, At, B1); PG8_BAR; PG8_SCHED;
            PG8_LDA(At, 0, 1); PG8_STAGE(PG8_SB(0, 0), b2, voffB); PG8_STAGE(PG8_SB(0, 1), b2 + hstepB, voffB); PG8_STAGE(PG8_SA(0, 0), a2, voffA);
            PG8_WAIT_V(8); PG8_WAIT_L(0); PG8_BAR; PG8_MMA(1, 0, At, B0); PG8_MMA(1, 1, At, B1); PG8_BAR; PG8_SCHED;
            PG8_LDB(B0, 1, 0); PG8_LDB(B1, 1, 1); PG8_SCHED; PG8_LDA(At, 1, 0); PG8_STAGE(PG8_SA(0, 1), a2 + hstepA, voffA);
            PG8_WAIT_V(8); PG8_WAIT_L(0); PG8_BAR; PG8_MMA(0, 0, At, B0); PG8_MMA(0, 1, At, B1); PG8_BAR; PG8_SCHED;
            PG8_LDA(At, 1, 1); PG8_STAGE(PG8_SB(1, 0), b3, voffB); PG8_STAGE(PG8_SB(1, 1), b3 + hstepB, voffB); PG8_STAGE(PG8_SA(1, 0), a3, voffA);
            PG8_WAIT_V(8); PG8_WAIT_L(0); PG8_BAR; PG8_MMA(1, 0, At, B0); PG8_MMA(1, 1, At, B1); PG8_BAR; PG8_SCHED;
            } else {
            PG8_LDB(B0, 0, 0); PG8_SCHED; PG8_LDA(At, 0, 0); PG8_STAGE(PG8_SA(1, 1), a1 + hstepA, voffA);
            PG8_WAIT_L(8); PG8_BAR; PG8_WAIT_L(0); PG8_MMA(0, 0, At, B0); PG8_BAR; PG8_SCHED;
            PG8_LDB(B1, 0, 1); PG8_STAGE(PG8_SB(0, 0), b2, voffB);
            PG8_BAR; PG8_WAIT_L(0); PG8_MMA(0, 1, At, B1); PG8_BAR;
            PG8_LDA(At, 0, 1); PG8_STAGE(PG8_SA(0, 0), a2, voffA);
            PG8_BAR; PG8_WAIT_L(0); PG8_MMA(1, 0, At, B0); PG8_BAR; PG8_SCHED;
            PG8_STAGE(PG8_SB(0, 1), b2 + hstepB, voffB);
            PG8_WAIT_V(6); PG8_BAR; PG8_MMA(1, 1, At, B1); PG8_BAR;
            PG8_LDB(B0, 1, 0); PG8_SCHED; PG8_LDA(At, 1, 0); PG8_STAGE(PG8_SA(0, 1), a2 + hstepA, voffA);
            PG8_WAIT_L(8); PG8_BAR; PG8_WAIT_L(0); PG8_MMA(0, 0, At, B0); PG8_BAR; PG8_SCHED;
            PG8_LDB(B1, 1, 1); PG8_STAGE(PG8_SB(1, 0), b3, voffB);
            PG8_BAR; PG8_WAIT_L(0); PG8_MMA(0, 1, At, B1); PG8_BAR;
            PG8_LDA(At, 1, 1); PG8_STAGE(PG8_SA(1, 0), a3, voffA);
            PG8_BAR; PG8_WAIT_L(0); PG8_MMA(1, 0, At, B0); PG8_BAR; PG8_SCHED;
            PG8_STAGE(PG8_SB(1, 1), b3 + hstepB, voffB);
            PG8_WAIT_V(6); PG8_BAR; PG8_MMA(1, 1, At, B1); PG8_BAR;
            }
        }
        if constexpr (ALIGN_EPI) { if (wr == 0) PG8_BAR; }
        if constexpr (!Epi::AFTER_DRAIN) { E(acc, cur, wr, wc, fr, fq); S.done(cur); }
        if (!has_next) break;
#pragma unroll
        for (int a = 0; a < 2; ++a)
#pragma unroll
            for (int b = 0; b < 2; ++b)
#pragma unroll
                for (int m = 0; m < 4; ++m)
#pragma unroll
                    for (int n = 0; n < 2; ++n) acc[a][b][m][n] = (f32x4){0.f, 0.f, 0.f, 0.f};
        cur = nxt; cA = nA; cB = nB; ++ui;
        if constexpr (ALIGN_EPI) { if (wr == 1) PG8_BAR; }
    }
    PG8_WAIT_V(0);
    if constexpr (!ALIGN_EPI) { if (wr == 0) PG8_BAR; }
    PG8_BAR;
    if constexpr (Epi::AFTER_DRAIN) { E.fused(acc, cur, wr, wc, fr, fq, lds, wid, lane); S.done(cur); }
#undef PG8_SA
#undef PG8_SB
#undef PG8_STAGE
#undef PG8_LDA
#undef PG8_LDB
#undef PG8_MMA
#undef PG8_WAIT_V
#undef PG8_WAIT_L
#undef PG8_BAR
#undef PG8_SCHED
}
}

namespace pg8 {
template <int ACT> struct EpiStore {
    static constexpr bool PERM = true, AFTER_DRAIN = false;
    bf16_t* O; int ldc; const float* cscale;
    __device__ __forceinline__ void operator()(const f32x4 (&acc)[2][2][4][2], const Unit& u, int wr, int wc, int fr, int fq) const {
        const int row0 = u.pm * BM + wr * 64 + fr, col0 = u.pn * BM + wc * 32 + 8 * fq;
        f32x4 cs[2][2];
#pragma unroll
        for (int bj = 0; bj < 2; ++bj)
#pragma unroll
            for (int n = 0; n < 2; ++n) cs[bj][n] = cscale ? *(const f32x4*)(cscale + col0 + bj * HALF + 4 * n) : (f32x4){1.f, 1.f, 1.f, 1.f};
#pragma unroll
        for (int ai = 0; ai < 2; ++ai)
#pragma unroll
            for (int m = 0; m < 4; ++m) { bf16_t* rowp = O + (size_t)(row0 + ai * HALF + m * 16) * ldc + col0;
#pragma unroll
                for (int bj = 0; bj < 2; ++bj) { f32x4 v0 = acc[ai][bj][m][0], v1 = acc[ai][bj][m][1];
                    if (ACT == 1) {
#pragma unroll
                        for (int e = 0; e < 4; ++e) { const float a = v0[e] > 0.f ? v0[e] : 0.f, b = v1[e] > 0.f ? v1[e] : 0.f; v0[e] = a * a; v1[e] = b * b; } }
                    v0 = v0 * cs[bj][0]; v1 = v1 * cs[bj][1];
                    u32x4 w; w.x = cvt_pk_bf16(v0[0], v0[1]); w.y = cvt_pk_bf16(v0[2], v0[3]); w.z = cvt_pk_bf16(v1[0], v1[1]); w.w = cvt_pk_bf16(v1[2], v1[3]);
                    *(u32x4*)(rowp + bj * HALF) = w; } }
    }
};
struct EpiRes {
    static constexpr bool PERM = false, AFTER_DRAIN = false;
    const float* src_lat; const float* src_ctx; float* dst_lat; float* dst_ctx; const float* gate;
    __device__ __forceinline__ void operator()(const f32x4 (&acc)[2][2][4][2], const Unit& u, int wr, int wc, int fr, int fq) const {
        const bool lat = u.pm < 64;
        const float* src = lat ? src_lat + (size_t)u.pm * BM * 1024 : src_ctx + (size_t)(u.pm - 64) * BM * 1024;
        float* dst = lat ? dst_lat + (size_t)u.pm * BM * 1024 : dst_ctx + (size_t)(u.pm - 64) * BM * 1024;
        const float* gr = gate + (size_t)(lat ? (u.pm >> 4) : 4) * 6144;
        const int col0 = u.pn * BM + wc * 32 + 4 * fq;
        f32x4 gv[2][2];
#pragma unroll
        for (int bj = 0; bj < 2; ++bj)
#pragma unroll
            for (int n = 0; n < 2; ++n) gv[bj][n] = *(const f32x4*)(gr + col0 + bj * HALF + n * 16);
#pragma unroll
        for (int ai = 0; ai < 2; ++ai)
#pragma unroll
            for (int m = 0; m < 4; ++m) { const size_t off = (size_t)(ai * HALF + wr * 64 + m * 16 + fr) * 1024 + col0;
#pragma unroll
                for (int bj = 0; bj < 2; ++bj)
#pragma unroll
                    for (int n = 0; n < 2; ++n) { const f32x4 s = *(const f32x4*)(src + off + bj * HALF + n * 16); *(f32x4*)(dst + off + bj * HALF + n * 16) = s + gv[bj][n] * acc[ai][bj][m][n]; } }
    }
};
struct EpiQkv {
    static constexpr bool PERM = false, AFTER_DRAIN = false;
    bf16_t *Q, *K, *V, *KC, *VC; const float* T; float qs;
    __device__ __forceinline__ void operator()(const f32x4 (&acc)[2][2][4][2], const Unit& u, int wr, int wc, int fr, int fq) const {
        typedef unsigned u32x2 __attribute__((ext_vector_type(2)));
        const bool lat = u.pm < 64;
#pragma unroll
        for (int ai = 0; ai < 2; ++ai)
#pragma unroll
            for (int m = 0; m < 4; ++m) {
                const int row = u.pm * BM + ai * HALF + wr * 64 + m * 16 + fr;
                f32x4 t0 = (f32x4){1.f, 0.f, 1.f, 0.f}, t1 = t0;
                if (lat) { const int t = row & 4095, pos = (wc & 1) ? (t & 63) : (t >> 6); const float* tp = T + (size_t)(pos * 16 + 4 * fq) * 2; t0 = *(const f32x4*)tp; t1 = *(const f32x4*)(tp + 4); }
                const f32x4 cc = (f32x4){t0[0], t0[2], t1[0], t1[2]}, ss = (f32x4){t0[1], t0[3], t1[1], t1[3]};
#pragma unroll
                for (int bj = 0; bj < 2; ++bj) {
                    const f32x4 x0 = acc[ai][bj][m][0], x1 = acc[ai][bj][m][1];
                    f32x4 o1, o2; bf16_t* p;
                    if (u.pn < 4) { o1 = (x0 * cc - x1 * ss) * qs; o2 = (x0 * ss + x1 * cc) * qs; p = Q + (size_t)row * 1024 + u.pn * BM + bj * HALF + wc * 32 + 4 * fq; }
                    else if (lat) { if (bj == 0) { o1 = x0 * cc - x1 * ss; o2 = x0 * ss + x1 * cc; p = K + (size_t)row * 128 + wc * 32 + 4 * fq; } else { o1 = x0; o2 = x1; p = V + (size_t)row * 128 + wc * 32 + 4 * fq; } }
                    else { o1 = x0; o2 = x1; p = (bj == 0 ? KC : VC) + (size_t)(row - 16384) * 128 + wc * 32 + 4 * fq; }
                    u32x2 w1, w2; w1.x = cvt_pk_bf16(o1[0], o1[1]); w1.y = cvt_pk_bf16(o1[2], o1[3]); w2.x = cvt_pk_bf16(o2[0], o2[1]); w2.y = cvt_pk_bf16(o2[2], o2[3]);
                    *(u32x2*)p = w1; *(u32x2*)(p + 16) = w2;
                }
            }
    }
};
struct QkvOrder {
    StaticOrder so; int G, c;
    __device__ void init(int G_, int c_) { so.init(16384, 1280, G_, c_); G = G_; c = c_; }
    __device__ bool next(int i, Unit& u) const { const long L = (long)i * G + c; if (L < 320) return so.next(i, u); if (L < 324) { u.pm = 64 + (int)(L - 320); u.pn = 4; return true; } return false; }
    __device__ __forceinline__ void a_ready(const Unit&) const {}
    __device__ __forceinline__ void done(const Unit&) const {}
};
}

struct Params { const float* in[18]; float* out; unsigned char* ws; };
__global__ void __launch_bounds__(NWAVES * 64, 2) fwd_kernel(Params prm) {
    extern __shared__ __attribute__((aligned(16))) unsigned char lds[];
    Frame F;
    F.lds = (LAS unsigned char*)lds;
    F.MISC = (volatile LAS unsigned*)(F.lds + MISC_OFF);
    F.tid = threadIdx.x; F.lane = F.tid & 63; F.wave = __builtin_amdgcn_readfirstlane(F.tid >> 6);
    F.G = gridDim.x; { const int bx = blockIdx.x; F.vcu = (F.G % 8 == 0) ? (bx % 8) * (F.G / 8) + bx / 8 : bx; }
    F.ws = prm.ws; F.out = prm.out;
#pragma unroll
    for (int i = 0; i < 18; ++i) F.in[i] = prm.in[i];
    F.ctl = (gu32*)(F.ws + WS_CTL);
    for (int u = F.tid; u < (LDS_BYTES - LDSCTL_OFF) / 4; u += NWAVES * 64) ((LAS unsigned*)(F.lds + LDSCTL_OFF))[u] = 0u;
    __syncthreads();
    XcdBarrier bar = xcd_barrier_post((unsigned*)(F.ctl + CW_BAR), F.MISC + 8);
#define GRID_BAR() xcd_barrier(bar)
    unsigned char* ws = F.ws;
    float* MOD = (float*)(ws + WS_MOD);
    float* CX = (float*)(ws + WS_CX);
    bf16* XN = (bf16*)(ws + WS_XN);
    bf16 *U = (bf16*)(ws + WS_U), *DP = (bf16*)(ws + WS_DP), *Y1 = (bf16*)(ws + WS_Y1), *H = (bf16*)(ws + WS_H);
    bf16 *Qb = (bf16*)(ws + WS_Q), *Kb = (bf16*)(ws + WS_K), *Vb = (bf16*)(ws + WS_V), *KC = (bf16*)(ws + WS_KC), *VC = (bf16*)(ws + WS_VC), *Ob = (bf16*)(ws + WS_O);
    float* RAW = (float*)(ws + WS_RAW);
    const bf16 *Win_t = (const bf16*)(ws + WS_WIN), *Wgrp_t = (const bf16*)(ws + WS_WGRP), *Wout_t = (const bf16*)(ws + WS_WOUT), *Wqkv_t = (const bf16*)(ws + WS_WQKV), *Wo_t = (const bf16*)(ws + WS_WO);
    const bf16 *W1_t = (const bf16*)(ws + WS_W1), *W2_t = (const bf16*)(ws + WS_W2);
    const float* MOD0 = MOD; const float* MOD1 = MOD + 5 * NMOD * D;

    p0_mod(F); p0_rope_table(F); p0_transposes(F);
    GRID_BAR();
#if FAST_GEMM
#define GEMM_RUN(EpiT, SchedT, g, S, E) pg8::gemm_phase<EpiT, SchedT, true, true>(F.lds, g, S, E)
    const int cid = (int)blockIdx.x;
#endif
    norm_mod_pass(F, F.in[I_X], F.in[I_CTX], MA, F.in[I_NMIXG], MOD0, 0, 1, XN);
    GRID_BAR();
#if FAST_GEMM
    { pg8::Gemm g{XN, Win_t, D, D, D, 0}; pg8::StaticOrder S; S.init(MA, D, F.G, cid); pg8::EpiStore<0> E{U, D, nullptr}; GEMM_RUN(pg8::EpiStore<0>, pg8::StaticOrder, g, S, E); }
#else
    naive_gemm(F, XN, D, Win_t, D, MA, D, D, NEpiBf16{U, D, 0, nullptr});
#endif
    GRID_BAR();
    pool_pass(F, U, DP);
    GRID_BAR();
#if FAST_GEMM
    { pg8::Gemm g{DP, Wgrp_t, 256, D, 256, 256}; pg8::StaticOrder S; S.init(MA, D, F.G, cid); pg8::EpiStore<0> E{Y1, D, F.in[I_PSCALE]}; GEMM_RUN(pg8::EpiStore<0>, pg8::StaticOrder, g, S, E); }
#else
    for (int g = 0; g < 4; ++g) naive_gemm(F, DP + g * 256, D, Wgrp_t + (size_t)g * 65536, 256, MA, 256, 256, NEpiBf16{Y1, D, g * 256, F.in[I_PSCALE]});
#endif
    GRID_BAR();
#if FAST_GEMM
    { pg8::Gemm g{Y1, Wout_t, D, D, D, 0}; pg8::StaticOrder S; S.init(MA, D, F.G, cid); pg8::EpiRes E{F.in[I_X], F.in[I_CTX], F.out, CX, MOD0 + 2 * D}; GEMM_RUN(pg8::EpiRes, pg8::StaticOrder, g, S, E); }
#else
    naive_gemm(F, Y1, D, Wout_t, D, MA, D, D, NEpiRes{F.in[I_X], F.in[I_CTX], F.out, CX, MOD0 + 2 * D});
#endif
    GRID_BAR();
    norm_mod_pass(F, F.out, CX, MA, F.in[I_NMLPG], MOD0, 3, 4, XN);
    GRID_BAR();
#if FAST_GEMM
    { pg8::Gemm g{XN, W1_t, D, D, D, 0}; pg8::StaticOrder S; S.init(MA, FF, F.G, cid); pg8::EpiStore<1> E{H, FF, nullptr}; GEMM_RUN(pg8::EpiStore<1>, pg8::StaticOrder, g, S, E); }
#else
    naive_gemm(F, XN, D, W1_t, D, MA, FF, D, NEpiSqRelu{H, FF});
#endif
    GRID_BAR();
#if FAST_GEMM
    { pg8::Gemm g{H, W2_t, FF, FF, FF, 0}; pg8::StaticOrder S; S.init(MA, D, F.G, cid); pg8::EpiRes E{F.out, CX, F.out, CX, MOD0 + 5 * D}; GEMM_RUN(pg8::EpiRes, pg8::StaticOrder, g, S, E); }
#else
    naive_gemm(F, H, FF, W2_t, FF, MA, D, FF, NEpiRes{F.out, CX, F.out, CX, MOD0 + 5 * D});
#endif
    GRID_BAR();
    norm_mod_pass(F, F.out, CX, MA, F.in[I_NMIXG] + D, MOD1, 0, 1, XN);
    GRID_BAR();
#if FAST_GEMM
    { pg8::Gemm g{XN, Wqkv_t, D, D, D, 0}; pg8::QkvOrder S; S.init(F.G, cid); pg8::EpiQkv E{Qb, Kb, Vb, KC, VC, (const float*)(ws + WS_ROPE), QS}; GEMM_RUN(pg8::EpiQkv, pg8::QkvOrder, g, S, E); }
    GRID_BAR();
#else
    naive_gemm(F, XN, D, Wqkv_t, D, ML, NQKV, D, NEpiQkvLat{RAW, Vb});
    naive_gemm(F, XN + (size_t)ML * D, D, Wqkv_t + (size_t)QDIM * D, D, MC, 256, D, NEpiKvCtx{KC, VC});
    GRID_BAR();
    naive_rope_pass(F, RAW, Qb, Kb);
    GRID_BAR();
#endif
    naive_attention(F, Qb, Kb, Vb, KC, VC, Ob);
    GRID_BAR();
#if FAST_GEMM
    { pg8::Gemm g{Ob, Wo_t, D, D, D, 0}; pg8::StaticOrder S; S.init(ML, D, F.G, cid); pg8::EpiRes E{F.out, CX, F.out, CX, MOD1 + 2 * D}; GEMM_RUN(pg8::EpiRes, pg8::StaticOrder, g, S, E); }
#else
    naive_gemm(F, Ob, D, Wo_t, D, ML, D, D, NEpiRes{F.out, CX, F.out, CX, MOD1 + 2 * D});
#endif
    GRID_BAR();
    norm_mod_pass(F, F.out, CX, ML, F.in[I_NMLPG] + D, MOD1, 3, 4, XN);
    GRID_BAR();
#if FAST_GEMM
    { pg8::Gemm g{XN, W1_t + (size_t)D * FF, D, D, D, 0}; pg8::StaticOrder S; S.init(ML, FF, F.G, cid); pg8::EpiStore<1> E{H, FF, nullptr}; GEMM_RUN(pg8::EpiStore<1>, pg8::StaticOrder, g, S, E); }
#else
    naive_gemm(F, XN, D, W1_t + (size_t)D * FF, D, ML, FF, D, NEpiSqRelu{H, FF});
#endif
    GRID_BAR();
#if FAST_GEMM
    { pg8::Gemm g{H, W2_t + (size_t)D * FF, FF, FF, FF, 0}; pg8::StaticOrder S; S.init(ML, D, F.G, cid); pg8::EpiRes E{F.out, CX, F.out, CX, MOD1 + 5 * D}; GEMM_RUN(pg8::EpiRes, pg8::StaticOrder, g, S, E); }
#else
    naive_gemm(F, H, FF, W2_t + (size_t)D * FF, FF, ML, D, FF, NEpiRes{F.out, CX, F.out, CX, MOD1 + 5 * D});
#endif
    GRID_BAR();
    final_norm_pass(F, F.out, F.in[I_FING]);
}

extern "C" void kernel_launch(void* const* d_in, const int* in_sizes, int n_in, void* d_out, int out_size, void* d_ws, size_t ws_size, hipStream_t stream) {
    static int grid = 0;
    if (grid == 0) {
        if (n_in != 18 || in_sizes[0] != ML * D || out_size != ML * D || ws_size < WS_END) { fprintf(stderr, "kernel_launch: unexpected problem shape (n_in %d, in0 %d, out %d, ws %zu); nothing launched\n", n_in, n_in > 0 ? in_sizes[0] : -1, out_size, ws_size); grid = -1; return; }
        int dev = 0, cus = 0;
        if (hipGetDevice(&dev) != hipSuccess || hipDeviceGetAttribute(&cus, hipDeviceAttributeMultiprocessorCount, dev) != hipSuccess) { fprintf(stderr, "kernel_launch: device query failed\n"); grid = -1; return; }
        if (hipFuncSetAttribute((const void*)fwd_kernel, hipFuncAttributeMaxDynamicSharedMemorySize, LDS_BYTES) != hipSuccess) { fprintf(stderr, "kernel_launch: hipFuncSetAttribute failed\n"); grid = -1; return; }
        int per_cu = 0;
        if (hipOccupancyMaxActiveBlocksPerMultiprocessor(&per_cu, (const void*)fwd_kernel, NWAVES * 64, LDS_BYTES) != hipSuccess || per_cu < 1) fprintf(stderr, "kernel_launch: note: occupancy query reports %d workgroups per CU\n", per_cu);
        (void)hipGetLastError();
        grid = cus;
    }
    if (grid < 0) return;
    if (hipMemsetAsync((char*)d_ws + WS_CTL, 0, CTL_ZERO_BYTES, stream) != hipSuccess) { fprintf(stderr, "kernel_launch: memset failed\n"); return; }
    Params a{};
    for (int i = 0; i < 18; ++i) a.in[i] = (const float*)d_in[i];
    a.out = (float*)d_out; a.ws = (unsigned char*)d_ws;
    hipLaunchKernelGGL(fwd_kernel, dim3(grid), dim3(NWAVES * 64), LDS_BYTES, stream, a);
    const hipError_t le = hipPeekAtLastError();
    if (le != hipSuccess) fprintf(stderr, "kernel_launch: launch failed: %s\n", hipGetErrorName(le));
}
```

```cpp
#include <hip/hip_runtime.h>
#include <cstdio>
#include <cstdint>

constexpr int D = 1024, BATCH = 4, SEQ = 4096, CTXL = 256, FF = 4096, NMOD = 6;
constexpr int ML = BATCH * SEQ;
constexpr int MC = BATCH * CTXL;
constexpr int MA = ML + MC;
constexpr int NQKV = 1280, QDIM = 1024, KVD = 128, HD = 64, NH = 16, NKV = 2;
constexpr float EPS = 1e-6f;
constexpr float QS = 0.125f * 1.4426950408889634f;
constexpr float LOG2E = 1.4426950408889634f;
constexpr int NWAVES = 8;

constexpr size_t MiB = 1u << 20;
constexpr size_t WS_CTL = 0, CTL_ZERO_BYTES = 1 * MiB;
constexpr size_t WS_MOD = 1 * MiB;
constexpr size_t WS_ROPE = 1 * MiB + 512 * 1024;
constexpr size_t WS_WIN = 2 * MiB, WS_WGRP = 4 * MiB, WS_WOUT = 5 * MiB, WS_WQKV = 7 * MiB, WS_WO = 10 * MiB;
constexpr size_t WS_W1 = 12 * MiB  , WS_W2 = 28 * MiB  ;
constexpr size_t WS_CX = 44 * MiB;
constexpr size_t WS_XN = 48 * MiB;
constexpr size_t WS_R = 82 * MiB;
constexpr size_t WS_U = WS_R, WS_DP = WS_R + 34 * MiB, WS_Y1 = WS_R + 68 * MiB;
constexpr size_t WS_H = WS_R;
constexpr size_t WS_Q = WS_R, WS_K = WS_R + 32 * MiB, WS_V = WS_R + 36 * MiB, WS_KC = WS_R + 40 * MiB, WS_VC = WS_KC + 256 * 1024, WS_O = WS_R + 42 * MiB;
constexpr size_t WS_RAW = 160 * MiB;
constexpr size_t WS_END = 256 * MiB;
constexpr int CW_BAR = 4096;

constexpr int RING_BYTES = 135168;
constexpr int LDSCTL_OFF = RING_BYTES, MISC_OFF = LDSCTL_OFF + 320;
constexpr int LDS_BYTES = 147456;

#define GAS __attribute__((address_space(1)))
#define LAS __attribute__((address_space(3)))
typedef unsigned short bf16;
typedef unsigned v4u __attribute__((ext_vector_type(4)));
typedef unsigned v2u __attribute__((ext_vector_type(2)));
typedef float f32x4 __attribute__((ext_vector_type(4)));
typedef short bf16x8 __attribute__((ext_vector_type(8)));
typedef GAS unsigned gu32;
#define RLX_AGENT __ATOMIC_RELAXED, __HIP_MEMORY_SCOPE_AGENT
#define LDS_WAIT() asm volatile("s_waitcnt lgkmcnt(0)" ::: "memory")
#define VM_WAIT() asm volatile("s_waitcnt vmcnt(0)" ::: "memory")
__device__ __forceinline__ unsigned f2bf(float f) { unsigned u = __builtin_bit_cast(unsigned, f); return (u + 0x7fffu + ((u >> 16) & 1u)) >> 16; }
__device__ __forceinline__ unsigned pk2(float lo, float hi) { return f2bf(lo) | (f2bf(hi) << 16); }
__device__ __forceinline__ float bf2f(unsigned short b) { return __builtin_bit_cast(float, (unsigned)b << 16); }

#define XB_TMO      128
#define XB_XCNT(j)  (256  + 64 * (j))
#define XB_XSUB(j)  (1280 + 64 * (j))
#define XB_XGEN(j)  (2304 + 64 * (j))
#define XB_TOP      3328
#define XB_TOPGEN   3392
#define XCD_BAR_WORDS 3456
#define XB_SPIN_CAP (1u << 18)

__device__ __forceinline__ unsigned xb_ld(unsigned* p)              { return __hip_atomic_load(p, __ATOMIC_RELAXED, __HIP_MEMORY_SCOPE_AGENT); }
__device__ __forceinline__ unsigned xb_add(unsigned* p, unsigned v) { return __hip_atomic_fetch_add(p, v, __ATOMIC_RELAXED, __HIP_MEMORY_SCOPE_AGENT); }
__device__ __forceinline__ unsigned xb_xcc_id() { return (unsigned)__builtin_amdgcn_s_getreg((3 << 11) | 20) & 0xFu; }
#define XB_SPIN(cond, bar) do { unsigned _sp = 0; while (cond) { __builtin_amdgcn_s_sleep(1); \
    if ((++_sp & 255u) == 0u) { if (xb_ld(&(bar)[XB_TMO])) break; if (_sp > XB_SPIN_CAP) { atomicAdd(&(bar)[XB_TMO], 1u); break; } } } } while (0)

struct XcdBarrier {
    unsigned* bar; unsigned x;
    volatile LAS unsigned* st;
};

__device__ __forceinline__ XcdBarrier xcd_barrier_post(unsigned* bar, volatile LAS unsigned* st) {
    XcdBarrier b; b.bar = bar; b.x = xb_xcc_id(); b.st = st;
    if (threadIdx.x == 0) (void)xb_add(&bar[XB_XCNT(b.x)], 1u);
    return b;
}
__device__ __forceinline__ void xcd_barrier_complete(unsigned* bar, unsigned x, unsigned& nloc, unsigned& nx) {
    const unsigned G = gridDim.x * gridDim.y * gridDim.z;
    unsigned sum, cnt, mine, sp = 0u;
    for (;;) {
        sum = 0u; cnt = 0u; mine = 0u;
#pragma unroll
        for (unsigned j = 0; j < 16; ++j) { const unsigned c = xb_ld(&bar[XB_XCNT(j)]); sum += c; cnt += (c > 0u) ? 1u : 0u; mine = (j == x) ? c : mine; }
        if (sum == G) break;
        __builtin_amdgcn_s_sleep(1);
        if ((++sp & 255u) == 0u) { if (xb_ld(&bar[XB_TMO])) break; if (sp > XB_SPIN_CAP) { atomicAdd(&bar[XB_TMO], 1u); break; } }
    }
    nloc = mine > 0u ? mine : 1u; nx = cnt > 0u ? cnt : 1u;
}

__device__ __forceinline__ void xcd_barrier(const XcdBarrier& b) {
    asm volatile("s_waitcnt vmcnt(0)" ::: "memory");
    __syncthreads();
    if (threadIdx.x == 0) {
        unsigned* bar = b.bar;
        __builtin_amdgcn_s_waitcnt(0);
        unsigned nloc = b.st[0], nx = b.st[1];
        if (nloc == 0u) { xcd_barrier_complete(bar, b.x, nloc, nx); b.st[0] = nloc; b.st[1] = nx; }
        const unsigned old = xb_add(&bar[XB_XSUB(b.x)], 1u);
        const unsigned gen = old / nloc;
        if (old + 1u == (gen + 1u) * nloc) {
            __builtin_amdgcn_fence(__ATOMIC_RELEASE, "agent");
            asm volatile("s_waitcnt vmcnt(0)" ::: "memory");
            const unsigned og = xb_add(&bar[XB_TOP], 1u);
            const unsigned tg = og / nx;
            if (og + 1u == (tg + 1u) * nx) xb_add(&bar[XB_TOPGEN], 1u);
            else XB_SPIN(xb_ld(&bar[XB_TOPGEN]) == tg, bar);
            __builtin_amdgcn_fence(__ATOMIC_ACQUIRE, "agent");
            xb_add(&bar[XB_XGEN(b.x)], 1u);
            asm volatile("s_waitcnt vmcnt(0)" ::: "memory");
        } else {
            XB_SPIN(xb_ld(&bar[XB_XGEN(b.x)]) == gen, bar);
            __builtin_amdgcn_fence(__ATOMIC_ACQUIRE, "agent");
            asm volatile("s_waitcnt vmcnt(0)" ::: "memory");
        }
    }
    __syncthreads();
}

struct Frame {
    LAS unsigned char* lds;
    volatile LAS unsigned* MISC;
    gu32* ctl;
    int tid, lane, wave;
    int vcu, G;
    unsigned char* ws;
    const float* in[18];
    float* out;
};
enum { I_X = 0, I_C, I_CTX, I_CCTX, I_ADAW, I_ADAB, I_NMIXG, I_NMLPG, I_PWIN, I_PWGRP, I_PSCALE, I_PWOUT, I_WQKV, I_SINK, I_WO, I_W1, I_W2, I_FING };

__device__ __forceinline__ float wave_sum(float v) {
#pragma unroll
    for (int o = 1; o < 64; o <<= 1) v += __shfl_xor(v, o);
    return v;
}
__device__ __forceinline__ int mod_row(int row) { return row < ML ? (row >> 12) : 4; }

__device__ __forceinline__ void p0_transpose_item(const float* W, int K, int N, bf16* WT, int row_off, LAS float* scr, int item, int lane) {
    const int nblk = N / 32, kb = item / nblk, nb = item % nblk, k0 = 64 * kb, n0 = 32 * nb;
#pragma unroll 8
    for (int i = 0; i < 32; ++i) { const int kk = 2 * i + (lane >> 5); scr[kk * 33 + (lane & 31)] = W[(size_t)(k0 + kk) * N + n0 + (lane & 31)]; }
    LDS_WAIT(); asm volatile("" ::: "memory");
    const int c = lane & 7;
#pragma unroll
    for (int j = 0; j < 4; ++j) { const int n = (lane >> 3) + 8 * j; const LAS float* s = scr + (8 * c) * 33 + n;
        v4u o; o.x = pk2(s[0 * 33], s[1 * 33]); o.y = pk2(s[2 * 33], s[3 * 33]); o.z = pk2(s[4 * 33], s[5 * 33]); o.w = pk2(s[6 * 33], s[7 * 33]);
        *(GAS v4u*)(WT + (size_t)(row_off + n0 + n) * K + k0 + 8 * c) = o; }
    LDS_WAIT(); asm volatile("" ::: "memory");
}
__device__ __forceinline__ void p0_transposes(Frame& F) {
    LAS float* scr = (LAS float*)(F.lds + F.wave * 16384);
    const int gw = F.vcu * NWAVES + F.wave, NGW = F.G * NWAVES;
    constexpr int I_SQ = (D / 64) * (D / 32);
    constexpr int I_G = (256 / 64) * (256 / 32);
    constexpr int I_QKV = (D / 64) * (NQKV / 32);
    constexpr int I_1 = (D / 64) * (FF / 32), I_2 = (FF / 64) * (D / 32);
    constexpr int NITEMS = I_SQ + 4 * I_G + I_SQ + I_QKV + I_SQ + 2 * I_1 + 2 * I_2;
    bf16* ws16 = (bf16*)F.ws;
    for (int it = gw; it < NITEMS; it += NGW) {
        int r = it;
        if (r < I_SQ) { p0_transpose_item(F.in[I_PWIN], D, D, (bf16*)(F.ws + WS_WIN), 0, scr, r, F.lane); continue; } r -= I_SQ;
        if (r < 4 * I_G) { const int g = r / I_G; p0_transpose_item(F.in[I_PWGRP] + (size_t)g * 65536, 256, 256, (bf16*)(F.ws + WS_WGRP) + (size_t)g * 65536, 0, scr, r % I_G, F.lane); continue; } r -= 4 * I_G;
        if (r < I_SQ) { p0_transpose_item(F.in[I_PWOUT], D, D, (bf16*)(F.ws + WS_WOUT), 0, scr, r, F.lane); continue; } r -= I_SQ;
        if (r < I_QKV) { p0_transpose_item(F.in[I_WQKV], D, NQKV, (bf16*)(F.ws + WS_WQKV), 0, scr, r, F.lane); continue; } r -= I_QKV;
        if (r < I_SQ) { p0_transpose_item(F.in[I_WO], D, D, (bf16*)(F.ws + WS_WO), 0, scr, r, F.lane); continue; } r -= I_SQ;
        if (r < 2 * I_1) { const int l = r / I_1; p0_transpose_item(F.in[I_W1] + (size_t)l * D * FF, D, FF, (bf16*)(F.ws + WS_W1) + (size_t)l * D * FF, 0, scr, r % I_1, F.lane); continue; } r -= 2 * I_1;
        { const int l = r / I_2; p0_transpose_item(F.in[I_W2] + (size_t)l * D * FF, FF, D, (bf16*)(F.ws + WS_W2) + (size_t)l * D * FF, 0, scr, r % I_2, F.lane); }
    }
    (void)ws16;
}
__device__ __forceinline__ void p0_mod(Frame& F) {
    LAS float* S = (LAS float*)F.lds;
    LAS float* P = (LAS float*)(F.lds + 20480);
    for (int i = F.tid; i < 5 * 1024; i += 512) { const int r = i >> 10, k = i & 1023; const float v = (r < 4) ? F.in[I_C][r * 1024 + k] : F.in[I_CCTX][k]; S[i] = v / (1.f + __expf(-v)); }
    __syncthreads();
    float* MOD = (float*)(F.ws + WS_MOD);
    for (int item = blockIdx.x; item < 256; item += F.G) {
        const int l = item >> 7, n0 = (item & 127) * 48;
        const float* W = F.in[I_ADAW] + (size_t)l * D * (NMOD * D);
        float acc[5] = {0.f, 0.f, 0.f, 0.f, 0.f};
        if (F.lane < 48) {
            const int k0 = F.wave * 128;
#pragma unroll 8
            for (int k = 0; k < 128; ++k) { const float w = W[(size_t)(k0 + k) * (NMOD * D) + n0 + F.lane];
#pragma unroll
                for (int r = 0; r < 5; ++r) acc[r] += S[r * 1024 + k0 + k] * w; }
#pragma unroll
            for (int r = 0; r < 5; ++r) P[(F.wave * 5 + r) * 48 + F.lane] = acc[r];
        }
        __syncthreads();
        if (F.tid < 240) { const int r = F.tid / 48, c = F.tid % 48; float s = F.in[I_ADAB][l * (NMOD * D) + n0 + c];
#pragma unroll
            for (int w = 0; w < 8; ++w) s += P[(w * 5 + r) * 48 + c];
            MOD[((size_t)l * 5 + r) * (NMOD * D) + n0 + c] = s; }
        __syncthreads();
    }
}
__device__ __forceinline__ void p0_rope_table(Frame& F) {
    const int g = blockIdx.x * 512 + F.tid;
    if (g < 1024) { const int pos = g >> 4, i = g & 15; const float inv = powf(10000.0f, -(float)(2 * i) / 32.0f); const float a = (float)pos * inv;
        float* T = (float*)(F.ws + WS_ROPE); T[2 * g] = cosf(a); T[2 * g + 1] = sinf(a); }
}
__device__ __forceinline__ void norm_mod_pass(Frame& F, const float* src_lat, const float* src_ctx, int nrows, const float* gvec, const float* modl, int ch_shift, int ch_scale, bf16* dst) {
    const int gw = F.vcu * NWAVES + F.wave, NGW = F.G * NWAVES;
    for (int row = gw; row < nrows; row += NGW) {
        const float* xrow = row < ML ? src_lat + (size_t)row * D : src_ctx + (size_t)(row - ML) * D;
        const f32x4* xr = (const f32x4*)xrow + F.lane;
        f32x4 v[4]; float s2 = 0.f;
#pragma unroll
        for (int j = 0; j < 4; ++j) { v[j] = xr[64 * j]; s2 += (v[j].x * v[j].x + v[j].y * v[j].y) + (v[j].z * v[j].z + v[j].w * v[j].w); }
        const float rstd = 1.0f / sqrtf(wave_sum(s2) * (1.f / D) + EPS);
        const float* mr = modl + (size_t)mod_row(row) * (NMOD * D);
        unsigned long long* o8 = (unsigned long long*)(dst + (size_t)row * D) + F.lane;
#pragma unroll
        for (int j = 0; j < 4; ++j) { const int c = 4 * F.lane + 256 * j;
            const f32x4 g = *(const f32x4*)(gvec + c), sh = *(const f32x4*)(mr + ch_shift * D + c), sc = *(const f32x4*)(mr + ch_scale * D + c);
            const f32x4 y = v[j] * rstd * g * (sc + 1.0f) + sh;
            o8[64 * j] = (unsigned long long)pk2(y.x, y.y) | ((unsigned long long)pk2(y.z, y.w) << 32); }
    }
}
__device__ __forceinline__ void final_norm_pass(Frame& F, float* xio, const float* gvec) {
    const int gw = F.vcu * NWAVES + F.wave, NGW = F.G * NWAVES;
    for (int row = gw; row < ML; row += NGW) {
        f32x4* xr = (f32x4*)(xio + (size_t)row * D) + F.lane;
        f32x4 v[4]; float s2 = 0.f;
#pragma unroll
        for (int j = 0; j < 4; ++j) { v[j] = xr[64 * j]; s2 += (v[j].x * v[j].x + v[j].y * v[j].y) + (v[j].z * v[j].z + v[j].w * v[j].w); }
        const float rstd = 1.0f / sqrtf(wave_sum(s2) * (1.f / D) + EPS);
#pragma unroll
        for (int j = 0; j < 4; ++j) { const f32x4 g = *(const f32x4*)(gvec + 4 * F.lane + 256 * j); xr[64 * j] = v[j] * rstd * g; }
    }
}
__device__ __forceinline__ void pool_pass(Frame& F, const bf16* U, bf16* DP) {
    const int NT = F.G * 512;
    for (int idx = blockIdx.x * 512 + F.tid; idx < MA * 128; idx += NT) {
        const int row = idx >> 7, c8 = (idx & 127) * 8, grp = c8 >> 8, hw = 1 << grp;
        int t, L; if (row < ML) { t = row & (SEQ - 1); L = SEQ; } else { t = (row - ML) & (CTXL - 1); L = CTXL; }
        const int base = row - t;
        const int lo = (t - hw) < 0 ? 0 : (t - hw), hi = (t + hw) > L ? L : (t + hw);
        float s[8] = {0.f, 0.f, 0.f, 0.f, 0.f, 0.f, 0.f, 0.f};
        for (int j = lo; j < hi; ++j) { const v4u w = *(const v4u*)(U + (size_t)(base + j) * D + c8);
            s[0] += bf2f(w.x & 0xffff); s[1] += bf2f(w.x >> 16); s[2] += bf2f(w.y & 0xffff); s[3] += bf2f(w.y >> 16);
            s[4] += bf2f(w.z & 0xffff); s[5] += bf2f(w.z >> 16); s[6] += bf2f(w.w & 0xffff); s[7] += bf2f(w.w >> 16); }
        const float inv = 1.0f / (float)(hi - lo);
        const v4u w = *(const v4u*)(U + (size_t)row * D + c8);
        v4u o;
        o.x = pk2(s[0] * inv - bf2f(w.x & 0xffff), s[1] * inv - bf2f(w.x >> 16));
        o.y = pk2(s[2] * inv - bf2f(w.y & 0xffff), s[3] * inv - bf2f(w.y >> 16));
        o.z = pk2(s[4] * inv - bf2f(w.z & 0xffff), s[5] * inv - bf2f(w.z >> 16));
        o.w = pk2(s[6] * inv - bf2f(w.w & 0xffff), s[7] * inv - bf2f(w.w >> 16));
        *(v4u*)(DP + (size_t)row * D + c8) = o;
    }
}

template <class Epi>
__device__ __forceinline__ void naive_gemm(Frame& F, const bf16* A, int lda, const bf16* Bt, int ldb, int M, int N, int K, const Epi& E) {
    LAS float* As = (LAS float*)F.lds; LAS float* Bs = As + 128 * 33;
    const int tid = F.tid, ty = tid >> 4, tx = tid & 15;
    const int ntn = N / 128, ntiles = (M / 128) * ntn;
    for (int t = blockIdx.x; t < ntiles; t += F.G) {
        const int tm = t / ntn, tn = t % ntn;
        float acc[4][8];
#pragma unroll
        for (int i = 0; i < 4; ++i)
#pragma unroll
            for (int j = 0; j < 8; ++j) acc[i][j] = 0.f;
        for (int k0 = 0; k0 < K; k0 += 32) {
            { const int r = tid >> 2, c = (tid & 3) * 8;
              const v4u a = *(const v4u*)(A + (size_t)(tm * 128 + r) * lda + k0 + c);
              const v4u b = *(const v4u*)(Bt + (size_t)(tn * 128 + r) * ldb + k0 + c);
              LAS float* ap = As + r * 33 + c; LAS float* bp = Bs + r * 33 + c;
              ap[0] = bf2f(a.x & 0xffff); ap[1] = bf2f(a.x >> 16); ap[2] = bf2f(a.y & 0xffff); ap[3] = bf2f(a.y >> 16);
              ap[4] = bf2f(a.z & 0xffff); ap[5] = bf2f(a.z >> 16); ap[6] = bf2f(a.w & 0xffff); ap[7] = bf2f(a.w >> 16);
              bp[0] = bf2f(b.x & 0xffff); bp[1] = bf2f(b.x >> 16); bp[2] = bf2f(b.y & 0xffff); bp[3] = bf2f(b.y >> 16);
              bp[4] = bf2f(b.z & 0xffff); bp[5] = bf2f(b.z >> 16); bp[6] = bf2f(b.w & 0xffff); bp[7] = bf2f(b.w >> 16); }
            __syncthreads();
#pragma unroll 4
            for (int kk = 0; kk < 32; ++kk) {
                float a[4], b[8];
#pragma unroll
                for (int i = 0; i < 4; ++i) a[i] = As[(ty * 4 + i) * 33 + kk];
#pragma unroll
                for (int j = 0; j < 8; ++j) b[j] = Bs[(tx + 16 * j) * 33 + kk];
#pragma unroll
                for (int i = 0; i < 4; ++i)
#pragma unroll
                    for (int j = 0; j < 8; ++j) acc[i][j] += a[i] * b[j];
            }
            __syncthreads();
        }
#pragma unroll
        for (int i = 0; i < 4; ++i)
#pragma unroll
            for (int j = 0; j < 8; ++j) E(tm * 128 + ty * 4 + i, tn * 128 + tx + 16 * j, acc[i][j]);
    }
}
struct NEpiBf16 { bf16* O; int ldc; int coff; const float* cscale;
    __device__ __forceinline__ void operator()(int row, int col, float v) const { const float s = cscale ? cscale[coff + col] : 1.f; O[(size_t)row * ldc + coff + col] = (bf16)f2bf(v * s); } };
struct NEpiSqRelu { bf16* O; int ldc;
    __device__ __forceinline__ void operator()(int row, int col, float v) const { const float r = v > 0.f ? v : 0.f; O[(size_t)row * ldc + col] = (bf16)f2bf(r * r); } };
struct NEpiRes { const float* src_lat; const float* src_ctx; float* dst_lat; float* dst_ctx; const float* gate;
    __device__ __forceinline__ void operator()(int row, int col, float v) const {
        const float g = gate[(size_t)mod_row(row) * (NMOD * D) + col];
        if (row < ML) dst_lat[(size_t)row * D + col] = src_lat[(size_t)row * D + col] + g * v;
        else dst_ctx[(size_t)(row - ML) * D + col] = src_ctx[(size_t)(row - ML) * D + col] + g * v; } };
struct NEpiQkvLat { float* RAW; bf16* V;
    __device__ __forceinline__ void operator()(int row, int col, float v) const { if (col < 1152) RAW[(size_t)row * 1152 + col] = v; else V[(size_t)row * KVD + col - 1152] = (bf16)f2bf(v); } };
struct NEpiKvCtx { bf16* KC; bf16* VC;
    __device__ __forceinline__ void operator()(int row, int col, float v) const { if (col < 128) KC[(size_t)row * KVD + col] = (bf16)f2bf(v); else VC[(size_t)row * KVD + col - 128] = (bf16)f2bf(v); } };

__device__ __forceinline__ void naive_rope_pass(Frame& F, const float* RAW, bf16* Q, bf16* K) {
    const float* T = (const float*)(F.ws + WS_ROPE);
    const int NT = F.G * 512;
    for (int idx = blockIdx.x * 512 + F.tid; idx < ML * 18 * 32; idx += NT) {
        const int j = idx & 31, hs = (idx >> 5) % 18, row = idx / (18 * 32);
        const int t = row & (SEQ - 1), ax = j >> 4, i = j & 15, pos = ax ? (t & 63) : (t >> 6);
        const float c = T[2 * (pos * 16 + i)], s = T[2 * (pos * 16 + i) + 1];
        const int d1 = ax * 32 + i, d2 = d1 + 16;
        const float u1 = RAW[(size_t)row * 1152 + hs * 64 + d1], u2 = RAW[(size_t)row * 1152 + hs * 64 + d2];
        const float o1 = u1 * c - u2 * s, o2 = u1 * s + u2 * c;
        if (hs < 16) { Q[(size_t)row * QDIM + hs * 64 + d1] = (bf16)f2bf(o1 * QS); Q[(size_t)row * QDIM + hs * 64 + d2] = (bf16)f2bf(o2 * QS); }
        else { K[(size_t)row * KVD + (hs - 16) * 64 + d1] = (bf16)f2bf(o1); K[(size_t)row * KVD + (hs - 16) * 64 + d2] = (bf16)f2bf(o2); }
    }
}
__device__ __forceinline__ float dot64(const float (&q)[64], const bf16* kp) {
    float s = 0.f;
#pragma unroll
    for (int c = 0; c < 8; ++c) { const v4u w = *(const v4u*)(kp + 8 * c);
        s += q[8 * c + 0] * bf2f(w.x & 0xffff) + q[8 * c + 1] * bf2f(w.x >> 16) + q[8 * c + 2] * bf2f(w.y & 0xffff) + q[8 * c + 3] * bf2f(w.y >> 16)
           + q[8 * c + 4] * bf2f(w.z & 0xffff) + q[8 * c + 5] * bf2f(w.z >> 16) + q[8 * c + 6] * bf2f(w.w & 0xffff) + q[8 * c + 7] * bf2f(w.w >> 16); }
    return s;
}
__device__ __forceinline__ void naive_attention(Frame& F, const bf16* Q, const bf16* K, const bf16* V, const bf16* KC, const bf16* VC, bf16* O) {
    const int NT = F.G * 512;
    for (int idx = blockIdx.x * 512 + F.tid; idx < NH * ML; idx += NT) {
        const int h = idx / ML, row = idx % ML, b = row >> 12, t = row & (SEQ - 1), g = h >> 3;
        float q[64];
#pragma unroll
        for (int c = 0; c < 8; ++c) { const v4u w = *(const v4u*)(Q + (size_t)row * QDIM + h * 64 + 8 * c);
            q[8 * c + 0] = bf2f(w.x & 0xffff); q[8 * c + 1] = bf2f(w.x >> 16); q[8 * c + 2] = bf2f(w.y & 0xffff); q[8 * c + 3] = bf2f(w.y >> 16);
            q[8 * c + 4] = bf2f(w.z & 0xffff); q[8 * c + 5] = bf2f(w.z >> 16); q[8 * c + 6] = bf2f(w.w & 0xffff); q[8 * c + 7] = bf2f(w.w >> 16); }
        const float sink2 = F.in[I_SINK][h] * LOG2E;
        const int jlo = (t - 128) < 0 ? 0 : (t - 128), jhi = (t + 128) > (SEQ - 1) ? (SEQ - 1) : (t + 128);
        float m = sink2;
        for (int j = jlo; j <= jhi; ++j) m = fmaxf(m, dot64(q, K + (size_t)(b * SEQ + j) * KVD + g * 64));
        for (int c = 0; c < CTXL; ++c) m = fmaxf(m, dot64(q, KC + (size_t)(b * CTXL + c) * KVD + g * 64));
        float l = exp2f(sink2 - m);
        float o[64];
#pragma unroll
        for (int d = 0; d < 64; ++d) o[d] = 0.f;
        for (int pass = 0; pass < 2; ++pass) {
            const int n = pass ? CTXL : (jhi - jlo + 1);
            const bf16* kb = pass ? KC + (size_t)(b * CTXL) * KVD + g * 64 : K + (size_t)(b * SEQ + jlo) * KVD + g * 64;
            const bf16* vb = pass ? VC + (size_t)(b * CTXL) * KVD + g * 64 : V + (size_t)(b * SEQ + jlo) * KVD + g * 64;
            for (int j = 0; j < n; ++j) {
                const float p = exp2f(dot64(q, kb + (size_t)j * KVD) - m); l += p;
#pragma unroll
                for (int c = 0; c < 8; ++c) { const v4u w = *(const v4u*)(vb + (size_t)j * KVD + 8 * c);
                    o[8 * c + 0] += p * bf2f(w.x & 0xffff); o[8 * c + 1] += p * bf2f(w.x >> 16); o[8 * c + 2] += p * bf2f(w.y & 0xffff); o[8 * c + 3] += p * bf2f(w.y >> 16);
                    o[8 * c + 4] += p * bf2f(w.z & 0xffff); o[8 * c + 5] += p * bf2f(w.z >> 16); o[8 * c + 6] += p * bf2f(w.w & 0xffff); o[8 * c + 7] += p * bf2f(w.w >> 16); }
            }
        }
        const float rl = 1.0f / l;
#pragma unroll
        for (int c = 0; c < 8; ++c) { v4u w; w.x = pk2(o[8 * c] * rl, o[8 * c + 1] * rl); w.y = pk2(o[8 * c + 2] * rl, o[8 * c + 3] * rl); w.z = pk2(o[8 * c + 4] * rl, o[8 * c + 5] * rl); w.w = pk2(o[8 * c + 6] * rl, o[8 * c + 7] * rl);
            *(v4u*)(O + (size_t)row * QDIM + h * 64 + 8 * c) = w; }
    }
}

#ifndef FAST_GEMM
#define FAST_GEMM 1
#endif
namespace pg8 {
#define PG8_LAS __attribute__((address_space(3)))
typedef unsigned short bf16_t;
typedef short bf16x8 __attribute__((ext_vector_type(8)));
typedef float f32x4 __attribute__((ext_vector_type(4)));
typedef unsigned u32x4 __attribute__((ext_vector_type(4)));
constexpr int BM = 256, BK = 64, HALF = 128, HTB = HALF * BK * 2  , STAGE_BYTES = 8 * HTB, NXCD = 8, WGM = 8;

__host__ __device__ __forceinline__ int lds_byte(int r, int c) { const int st = (r >> 4) * 2 + (c >> 5), rr = r & 15, cc = c & 31, ob = rr * 64 + cc * 2; return st * 1024 + (ob ^ (((ob >> 9) & 1) << 5)); }
__host__ __device__ __forceinline__ void stage_rc(int b, int& R, int& C) { const int st = b / 1024, sb = b % 1024, swz = sb ^ (((sb >> 9) & 1) << 5); R = (st >> 1) * 16 + swz / 64; C = (st & 1) * 32 + (swz % 64) / 2; }
__host__ __device__ __forceinline__ int perm32(int rho) { const int n = rho >> 4, i = rho & 15; return 8 * (i >> 2) + 4 * n + (i & 3); }

struct Unit { int pm, pn; };
struct Gemm { const bf16_t* A; const bf16_t* Bt; int K, lda, ldb, a_pn_off; };

struct StaticOrder {
    int nM, nN, nwg, G, c;
    __host__ __device__ void init(int M, int N, int G_, int c_) { nM = M / BM; nN = N / BM; nwg = nM * nN; G = G_; c = c_; }
    __host__ __device__ bool next(int i, Unit& u) const {
        const long L = (long)i * G + c; if (L >= nwg) return false;
        int wgid = (int)L; { const int q = nwg / NXCD, r = nwg % NXCD, xcd = wgid % NXCD, off = wgid / NXCD; wgid = (xcd < r ? xcd * (q + 1) : r * (q + 1) + (xcd - r) * q) + off; }
        const int nig = WGM * nN, gid = wgid / nig, fm = gid * WGM, gsz = (nM - fm) < WGM ? (nM - fm) : WGM;
        u.pm = fm + ((wgid % nig) % gsz); u.pn = (wgid % nig) / gsz; return true;
    }
    __device__ __forceinline__ void a_ready(const Unit&) const {}
    __device__ __forceinline__ void done(const Unit&) const {}
};

__device__ __forceinline__ unsigned cvt_pk_bf16(float lo, float hi) { unsigned r; asm volatile("v_cvt_pk_bf16_f32 %0, %1, %2" : "=v"(r) : "v"(lo), "v"(hi)); return r; }

template <class Epi, class Sched, bool ALIGN_EPI = false, bool SP2 = false>
__device__ __forceinline__ void gemm_phase(PG8_LAS unsigned char* lds, const Gemm g, const Sched& S, const Epi& E) {
    const int tid = threadIdx.x, wid = __builtin_amdgcn_readfirstlane(tid >> 6), lane = tid & 63, wr = wid >> 2, wc = wid & 3, fr = lane & 15, fq = lane >> 4;
    const int K = g.K, nt = K / BK;
    unsigned voffA[2], voffB[2];
#pragma unroll
    for (int i = 0; i < 2; ++i) { int R, C; stage_rc(tid * 16 + i * 8192, R, C); const int Rb = Epi::PERM ? ((R & ~31) + perm32(R & 31)) : R;
        voffA[i] = (unsigned)(R * g.lda + C) * 2u; voffB[i] = (unsigned)(Rb * g.ldb + C) * 2u; }
    const size_t kstep = (size_t)(BK * 2);
    const size_t hstepA = (size_t)HALF * g.lda * 2, hstepB = (size_t)HALF * g.ldb * 2;
    const size_t tstepA = 2 * hstepA, tstepB = 2 * hstepB, pnoffA = (size_t)g.a_pn_off * 2;
    const unsigned ldsw = (unsigned)wid * 1024u;
    const int aoff = lds_byte(wr * 64 + fr, fq * 8), boff = lds_byte(wc * 32 + fr, fq * 8);
#define PG8_SA(b, h) (((b) * 2 + (h)) * HTB)
#define PG8_SB(b, h) ((4 + (b) * 2 + (h)) * HTB)
#define PG8_STAGE(bufoff, gbase, voff) do { _Pragma("unroll") for (int _i = 0; _i < 2; ++_i) \
        __builtin_amdgcn_global_load_lds((const unsigned*)((const char*)(gbase) + (voff)[_i]), (PG8_LAS unsigned*)(lds + (bufoff) + ldsw + _i * 8192), 16, 0, 0); } while (0)
#define PG8_LDA(dst, b, h) do { _Pragma("unroll") for (int m = 0; m < 4; ++m) _Pragma("unroll") for (int k = 0; k < 2; ++k) dst[m][k] = *(const PG8_LAS bf16x8*)(lds + PG8_SA(b, h) + aoff + m * 2048 + k * 1024); } while (0)
#define PG8_LDB(dst, b, h) do { _Pragma("unroll") for (int n = 0; n < 2; ++n) _Pragma("unroll") for (int k = 0; k < 2; ++k) dst[n][k] = *(const PG8_LAS bf16x8*)(lds + PG8_SB(b, h) + boff + n * 2048 + k * 1024); } while (0)
#define PG8_MMA(ai, bj, At, Bt) do { __builtin_amdgcn_s_setprio(1); _Pragma("unroll") for (int m = 0; m < 4; ++m) _Pragma("unroll") for (int n = 0; n < 2; ++n) _Pragma("unroll") for (int k = 0; k < 2; ++k) \
        acc[ai][bj][m][n] = __builtin_amdgcn_mfma_f32_16x16x32_bf16(Bt[n][k], At[m][k], acc[ai][bj][m][n], 0, 0, 0); __builtin_amdgcn_s_setprio(0); } while (0)
#define PG8_WAIT_V(n) asm volatile("s_waitcnt vmcnt(" #n ")" ::: "memory")
#define PG8_WAIT_L(n) asm volatile("s_waitcnt lgkmcnt(" #n ")" ::: "memory")
#define PG8_BAR __builtin_amdgcn_s_barrier()
#define PG8_SCHED __builtin_amdgcn_sched_barrier(0)
    Unit cur, nxt; int ui = 0;
    if (!S.next(0, cur)) return;
    f32x4 acc[2][2][4][2];
#pragma unroll
    for (int a = 0; a < 2; ++a)
#pragma unroll
        for (int b = 0; b < 2; ++b)
#pragma unroll
            for (int m = 0; m < 4; ++m)
#pragma unroll
                for (int n = 0; n < 2; ++n) acc[a][b][m][n] = (f32x4){0.f, 0.f, 0.f, 0.f};
    bf16x8 At[4][2], B0[2][2], B1[2][2];
    const char* cA = (const char*)g.A + (size_t)cur.pm * tstepA + (size_t)cur.pn * pnoffA; const char* cB = (const char*)g.Bt + (size_t)cur.pn * tstepB;
    S.a_ready(cur);
    if constexpr (SP2) {
        PG8_STAGE(PG8_SB(0, 0), cB, voffB); PG8_STAGE(PG8_SB(0, 1), cB + hstepB, voffB); PG8_STAGE(PG8_SA(0, 0), cA, voffA); PG8_STAGE(PG8_SA(0, 1), cA + hstepA, voffA);
        if (wr == 1) PG8_BAR;
        PG8_WAIT_V(2); PG8_BAR;
        PG8_STAGE(PG8_SB(1, 0), cB + kstep, voffB); PG8_STAGE(PG8_SA(1, 0), cA + kstep, voffA); PG8_STAGE(PG8_SB(1, 1), cB + hstepB + kstep, voffB);
        PG8_WAIT_V(6); PG8_BAR;
    } else {
        PG8_STAGE(PG8_SB(0, 0), cB, voffB); PG8_STAGE(PG8_SA(0, 0), cA, voffA); PG8_STAGE(PG8_SB(0, 1), cB + hstepB, voffB); PG8_STAGE(PG8_SA(0, 1), cA + hstepA, voffA);
        if (wr == 1) PG8_BAR;
        PG8_WAIT_V(4); PG8_BAR;
        PG8_STAGE(PG8_SB(1, 0), cB + kstep, voffB); PG8_STAGE(PG8_SA(1, 0), cA + kstep, voffA); PG8_STAGE(PG8_SB(1, 1), cB + hstepB + kstep, voffB);
        PG8_WAIT_V(6); PG8_BAR;
    }
    for (;;) {
        const bool has_next = S.next(ui + 1, nxt);
        const char* nA = has_next ? (const char*)g.A + (size_t)nxt.pm * tstepA + (size_t)nxt.pn * pnoffA : cA; const char* nB = has_next ? (const char*)g.Bt + (size_t)nxt.pn * tstepB : cB;
        for (int t = 0; t < nt; t += 2) {
            const bool last = (t == nt - 2);
            const char* a1 = cA + (size_t)(t + 1) * kstep;
            const char* a2 = last ? nA : cA + (size_t)(t + 2) * kstep; const char* b2 = last ? nB : cB + (size_t)(t + 2) * kstep;
            const char* a3 = a2 + kstep; const char* b3 = b2 + kstep;
            if (last && has_next) S.a_ready(nxt);
            if constexpr (SP2) {
            PG8_LDB(B0, 0, 0); PG8_LDB(B1, 0, 1); PG8_SCHED; PG8_LDA(At, 0, 0); PG8_STAGE(PG8_SA(1, 1), a1 + hstepA, voffA);
            PG8_WAIT_V(8); PG8_WAIT_L(0); PG8_BAR; PG8_MMA(0, 0, At, B0); PG8_MMA(0, 1, At, B1); PG8_BAR; PG8_SCHED;
            PG8_LDA(At, 0, 1); PG8_STAGE(PG8_SB(0, 0), b2, voffB); PG8_STAGE(PG8_SB(0, 1), b2 + hstepB, voffB); PG8_STAGE(PG8_SA(0, 0), a2, voffA);
            PG8_WAIT_V(8); PG8_WAIT_L(0); PG8_BAR; PG8_MMA(1, 0, At, B0); PG8_MMA(1, 1, At, B1); PG8_BAR; PG8_SCHED;
            PG8_LDB(B0, 1, 0); PG8_LDB(B1, 1, 1); PG8_SCHED; PG8_LDA(At, 1, 0); PG8_STAGE(PG8_SA(0, 1), a2 + hstepA, voffA);
            PG8_WAIT_V(8); PG8_WAIT_L(0); PG8_BAR; PG8_MMA(0, 0, At, B0); PG8_MMA(0, 1, At, B1); PG8_BAR; PG8_SCHED;
            PG8_LDA(At, 1, 1); PG8_STAGE(PG8_SB(1, 0), b3, voffB); PG8_STAGE(PG8_SB(1, 1), b3 + hstepB, voffB); PG8_STAGE(PG8_SA(1, 0), a3, voffA);
            PG8_WAIT_V(8); PG8_WAIT_L(0); PG8_BAR; PG8_MMA(1, 0, At, B0); PG8_MMA(1, 1, At, B1); PG8_BAR; PG8_SCHED;
            } else {
            PG8_LDB(B0, 0, 0); PG8_SCHED; PG8_LDA(At, 0, 0); PG8_STAGE(PG8_SA(1, 1), a1 + hstepA, voffA);
            PG8_WAIT_L(8); PG8_BAR; PG8_WAIT_L(0); PG8_MMA(0, 0, At, B0); PG8_BAR; PG8_SCHED;
            PG8_LDB(B1, 0, 1); PG8_STAGE(PG8_SB(0, 0), b2, voffB);
            PG8_BAR; PG8_WAIT_L(0); PG8_MMA(0, 1, At, B1); PG8_BAR;
            PG8_LDA(At, 0, 1); PG8_STAGE(PG8_SA(0, 0), a2, voffA);
            PG8_BAR; PG8_WAIT_L(0); PG8_MMA(1, 0, At, B0); PG8_BAR; PG8_SCHED;
            PG8_STAGE(PG8_SB(0, 1), b2 + hstepB, voffB);
            PG8_WAIT_V(6); PG8_BAR; PG8_MMA(1, 1, At, B1); PG8_BAR;
            PG8_LDB(B0, 1, 0); PG8_SCHED; PG8_LDA(At, 1, 0); PG8_STAGE(PG8_SA(0, 1), a2 + hstepA, voffA);
            PG8_WAIT_L(8); PG8_BAR; PG8_WAIT_L(0); PG8_MMA(0, 0, At, B0); PG8_BAR; PG8_SCHED;
            PG8_LDB(B1, 1, 1); PG8_STAGE(PG8_SB(1, 0), b3, voffB);
            PG8_BAR; PG8_WAIT_L(0); PG8_MMA(0, 1, At, B1); PG8_BAR;
            PG8_LDA(At, 1, 1); PG8_STAGE(PG8_SA(1, 0), a3, voffA);
            PG8_BAR; PG8_WAIT_L(0); PG8_MMA(1, 0, At, B0); PG8_BAR; PG8_SCHED;
            PG8_STAGE(PG8_SB(1, 1), b3 + hstepB, voffB);
            PG8_WAIT_V(6); PG8_BAR; PG8_MMA(1, 1, At, B1); PG8_BAR;
            }
        }
        if constexpr (ALIGN_EPI) { if (wr == 0) PG8_BAR; }
        if constexpr (!Epi::AFTER_DRAIN) { E(acc, cur, wr, wc, fr, fq); S.done(cur); }
        if (!has_next) break;
#pragma unroll
        for (int a = 0; a < 2; ++a)
#pragma unroll
            for (int b = 0; b < 2; ++b)
#pragma unroll
                for (int m = 0; m < 4; ++m)
#pragma unroll
                    for (int n = 0; n < 2; ++n) acc[a][b][m][n] = (f32x4){0.f, 0.f, 0.f, 0.f};
        cur = nxt; cA = nA; cB = nB; ++ui;
        if constexpr (ALIGN_EPI) { if (wr == 1) PG8_BAR; }
    }
    PG8_WAIT_V(0);
    if constexpr (!ALIGN_EPI) { if (wr == 0) PG8_BAR; }
    PG8_BAR;
    if constexpr (Epi::AFTER_DRAIN) { E.fused(acc, cur, wr, wc, fr, fq, lds, wid, lane); S.done(cur); }
#undef PG8_SA
#undef PG8_SB
#undef PG8_STAGE
#undef PG8_LDA
#undef PG8_LDB
#undef PG8_MMA
#undef PG8_WAIT_V
#undef PG8_WAIT_L
#undef PG8_BAR
#undef PG8_SCHED
}
}

namespace pg8 {
template <int ACT> struct EpiStore {
    static constexpr bool PERM = true, AFTER_DRAIN = false;
    bf16_t* O; int ldc; const float* cscale;
    __device__ __forceinline__ void operator()(const f32x4 (&acc)[2][2][4][2], const Unit& u, int wr, int wc, int fr, int fq) const {
        const int row0 = u.pm * BM + wr * 64 + fr, col0 = u.pn * BM + wc * 32 + 8 * fq;
        f32x4 cs[2][2];
#pragma unroll
        for (int bj = 0; bj < 2; ++bj)
#pragma unroll
            for (int n = 0; n < 2; ++n) cs[bj][n] = cscale ? *(const f32x4*)(cscale + col0 + bj * HALF + 4 * n) : (f32x4){1.f, 1.f, 1.f, 1.f};
#pragma unroll
        for (int ai = 0; ai < 2; ++ai)
#pragma unroll
            for (int m = 0; m < 4; ++m) { bf16_t* rowp = O + (size_t)(row0 + ai * HALF + m * 16) * ldc + col0;
#pragma unroll
                for (int bj = 0; bj < 2; ++bj) { f32x4 v0 = acc[ai][bj][m][0], v1 = acc[ai][bj][m][1];
                    if (ACT == 1) {
#pragma unroll
                        for (int e = 0; e < 4; ++e) { const float a = v0[e] > 0.f ? v0[e] : 0.f, b = v1[e] > 0.f ? v1[e] : 0.f; v0[e] = a * a; v1[e] = b * b; } }
                    v0 = v0 * cs[bj][0]; v1 = v1 * cs[bj][1];
                    u32x4 w; w.x = cvt_pk_bf16(v0[0], v0[1]); w.y = cvt_pk_bf16(v0[2], v0[3]); w.z = cvt_pk_bf16(v1[0], v1[1]); w.w = cvt_pk_bf16(v1[2], v1[3]);
                    *(u32x4*)(rowp + bj * HALF) = w; } }
    }
};
struct EpiRes {
    static constexpr bool PERM = false, AFTER_DRAIN = false;
    const float* src_lat; const float* src_ctx; float* dst_lat; float* dst_ctx; const float* gate;
    __device__ __forceinline__ void operator()(const f32x4 (&acc)[2][2][4][2], const Unit& u, int wr, int wc, int fr, int fq) const {
        const bool lat = u.pm < 64;
        const float* src = lat ? src_lat + (size_t)u.pm * BM * 1024 : src_ctx + (size_t)(u.pm - 64) * BM * 1024;
        float* dst = lat ? dst_lat + (size_t)u.pm * BM * 1024 : dst_ctx + (size_t)(u.pm - 64) * BM * 1024;
        const float* gr = gate + (size_t)(lat ? (u.pm >> 4) : 4) * 6144;
        const int col0 = u.pn * BM + wc * 32 + 4 * fq;
        f32x4 gv[2][2];
#pragma unroll
        for (int bj = 0; bj < 2; ++bj)
#pragma unroll
            for (int n = 0; n < 2; ++n) gv[bj][n] = *(const f32x4*)(gr + col0 + bj * HALF + n * 16);
#pragma unroll
        for (int ai = 0; ai < 2; ++ai)
#pragma unroll
            for (int m = 0; m < 4; ++m) { const size_t off = (size_t)(ai * HALF + wr * 64 + m * 16 + fr) * 1024 + col0;
#pragma unroll
                for (int bj = 0; bj < 2; ++bj)
#pragma unroll
                    for (int n = 0; n < 2; ++n) { const f32x4 s = *(const f32x4*)(src + off + bj * HALF + n * 16); *(f32x4*)(dst + off + bj * HALF + n * 16) = s + gv[bj][n] * acc[ai][bj][m][n]; } }
    }
};
struct EpiQkv {
    static constexpr bool PERM = false, AFTER_DRAIN = false;
    bf16_t *Q, *K, *V, *KC, *VC; const float* T; float qs;
    __device__ __forceinline__ void operator()(const f32x4 (&acc)[2][2][4][2], const Unit& u, int wr, int wc, int fr, int fq) const {
        typedef unsigned u32x2 __attribute__((ext_vector_type(2)));
        const bool lat = u.pm < 64;
#pragma unroll
        for (int ai = 0; ai < 2; ++ai)
#pragma unroll
            for (int m = 0; m < 4; ++m) {
                const int row = u.pm * BM + ai * HALF + wr * 64 + m * 16 + fr;
                f32x4 t0 = (f32x4){1.f, 0.f, 1.f, 0.f}, t1 = t0;
                if (lat) { const int t = row & 4095, pos = (wc & 1) ? (t & 63) : (t >> 6); const float* tp = T + (size_t)(pos * 16 + 4 * fq) * 2; t0 = *(const f32x4*)tp; t1 = *(const f32x4*)(tp + 4); }
                const f32x4 cc = (f32x4){t0[0], t0[2], t1[0], t1[2]}, ss = (f32x4){t0[1], t0[3], t1[1], t1[3]};
#pragma unroll
                for (int bj = 0; bj < 2; ++bj) {
                    const f32x4 x0 = acc[ai][bj][m][0], x1 = acc[ai][bj][m][1];
                    f32x4 o1, o2; bf16_t* p;
                    if (u.pn < 4) { o1 = (x0 * cc - x1 * ss) * qs; o2 = (x0 * ss + x1 * cc) * qs; p = Q + (size_t)row * 1024 + u.pn * BM + bj * HALF + wc * 32 + 4 * fq; }
                    else if (lat) { if (bj == 0) { o1 = x0 * cc - x1 * ss; o2 = x0 * ss + x1 * cc; p = K + (size_t)row * 128 + wc * 32 + 4 * fq; } else { o1 = x0; o2 = x1; p = V + (size_t)row * 128 + wc * 32 + 4 * fq; } }
                    else { o1 = x0; o2 = x1; p = (bj == 0 ? KC : VC) + (size_t)(row - 16384) * 128 + wc * 32 + 4 * fq; }
                    u32x2 w1, w2; w1.x = cvt_pk_bf16(o1[0], o1[1]); w1.y = cvt_pk_bf16(o1[2], o1[3]); w2.x = cvt_pk_bf16(o2[0], o2[1]); w2.y = cvt_pk_bf16(o2[2], o2[3]);
                    *(u32x2*)p = w1; *(u32x2*)(p + 16) = w2;
                }
            }
    }
};
struct QkvOrder {
    StaticOrder so; int G, c;
    __device__ void init(int G_, int c_) { so.init(16384, 1280, G_, c_); G = G_; c = c_; }
    __device__ bool next(int i, Unit& u) const { const long L = (long)i * G + c; if (L < 320) return so.next(i, u); if (L < 324) { u.pm = 64 + (int)(L - 320); u.pn = 4; return true; } return false; }
    __device__ __forceinline__ void a_ready(const Unit&) const {}
    __device__ __forceinline__ void done(const Unit&) const {}
};
}

#ifndef FAST_ATTN
#define FAST_ATTN 1
#endif
namespace att {
typedef float f32x16 __attribute__((ext_vector_type(16)));
typedef short s16x4 __attribute__((ext_vector_type(4)));
typedef short v4i16_t __attribute__((ext_vector_type(4)));
typedef LAS const unsigned char* lptr;
constexpr int SLOT = 16384, NSLOT = 6, WSF_OFF = NSLOT * SLOT, OST_OFF = WSF_OFF + 2048, ATT_LDS = OST_OFF + 8 * 4096;
constexpr float NEG = -1e30f;
__device__ __forceinline__ void dma16(const void* gsrc, LAS unsigned char* ldst) { __builtin_amdgcn_global_load_lds((const unsigned*)gsrc, (LAS unsigned*)ldst, 16, 0, 0); }
__device__ __forceinline__ s16x4 vtr(lptr p) { return __builtin_bit_cast(s16x4, __builtin_amdgcn_ds_read_tr16_b64_v4i16((LAS v4i16_t*)p)); }
__device__ __forceinline__ unsigned cvtpk(float lo, float hi) { unsigned r; asm volatile("v_cvt_pk_bf16_f32 %0, %1, %2" : "=v"(r) : "v"(lo), "v"(hi)); return r; }
__device__ __forceinline__ float swap_max(float v) { auto rr = __builtin_amdgcn_permlane32_swap(__float_as_uint(v), __float_as_uint(v), false, false); return fmaxf(__uint_as_float(rr[0]), __uint_as_float(rr[1])); }
__device__ __forceinline__ float swap_sum(float v) { auto rr = __builtin_amdgcn_permlane32_swap(__float_as_uint(v), __float_as_uint(v), false, false); return __uint_as_float(rr[0]) + __uint_as_float(rr[1]); }

__device__ __forceinline__ void tile_step(lptr kb, lptr vp, const bf16x8 (&qr)[4], f32x16 (&o)[2], float& m, float& l, LAS float* wsf, int r32, int hi, bool partial, int dl) {
    f32x16 p0, p1;
#pragma unroll
    for (int d0 = 0; d0 < 4; ++d0) {
        const bf16x8 b0 = *(const LAS bf16x8*)(kb + d0 * 2048), b1 = *(const LAS bf16x8*)(kb + d0 * 2048 + 512);
        if (d0 == 0) { const f32x16 z = {}; p0 = __builtin_amdgcn_mfma_f32_32x32x16_bf16(b0, qr[0], z, 0, 0, 0); p1 = __builtin_amdgcn_mfma_f32_32x32x16_bf16(b1, qr[0], z, 0, 0, 0); }
        else { p0 = __builtin_amdgcn_mfma_f32_32x32x16_bf16(b0, qr[d0], p0, 0, 0, 0); p1 = __builtin_amdgcn_mfma_f32_32x32x16_bf16(b1, qr[d0], p1, 0, 0, 0); }
    }
    if (partial) {
#pragma unroll
        for (int r = 0; r < 16; ++r) { const int c = dl + (r & 3) + 8 * (r >> 2); if ((unsigned)c > 256u) p0[r] = NEG; if ((unsigned)(c + 32) > 256u) p1[r] = NEG; }
    }
    float rm = fmaxf(p0[0], p1[0]);
#pragma unroll
    for (int r = 1; r < 16; ++r) rm = fmaxf(rm, fmaxf(p0[r], p1[r]));
    rm = swap_max(rm);
    const float mn = fmaxf(m, rm), alpha = __builtin_amdgcn_exp2f(m - mn);
    m = mn;
    float rs = 0.f;
#pragma unroll
    for (int r = 0; r < 16; ++r) { p0[r] = __builtin_amdgcn_exp2f(p0[r] - mn); p1[r] = __builtin_amdgcn_exp2f(p1[r] - mn); rs += p0[r] + p1[r]; }
    rs = swap_sum(rs);
    l = l * alpha + rs;
    if (!__all(alpha == 1.0f)) {
        if (hi == 0) wsf[r32] = alpha;
#pragma unroll
        for (int k = 0; k < 4; ++k) { const f32x4 a = *(const LAS f32x4*)(wsf + 8 * k + 4 * hi);
#pragma unroll
            for (int e = 0; e < 4; ++e) { o[0][4 * k + e] *= a[e]; o[1][4 * k + e] *= a[e]; } }
    }
    v4u pw[4];
#pragma unroll
    for (int i = 0; i < 4; ++i) { pw[0][i] = cvtpk(p0[2 * i], p0[2 * i + 1]); pw[1][i] = cvtpk(p0[8 + 2 * i], p0[8 + 2 * i + 1]); pw[2][i] = cvtpk(p1[2 * i], p1[2 * i + 1]); pw[3][i] = cvtpk(p1[8 + 2 * i], p1[8 + 2 * i + 1]); }
#pragma unroll
    for (int d0 = 0; d0 < 2; ++d0)
#pragma unroll
        for (int s = 0; s < 4; ++s) {
            const s16x4 lo = vtr(vp + d0 * 4096 + s * 1024), hv = vtr(vp + d0 * 4096 + s * 1024 + 512);
            const bf16x8 vf = (bf16x8){lo[0], lo[1], lo[2], lo[3], hv[0], hv[1], hv[2], hv[3]};
            o[d0] = __builtin_amdgcn_mfma_f32_32x32x16_bf16(__builtin_bit_cast(bf16x8, pw[s]), vf, o[d0], 0, 0, 0);
        }
}
struct Args { const bf16* Q; const bf16* K; const bf16* V; const bf16* KC; const bf16* VC; bf16* O; const float* sink; };

__device__ __forceinline__ void attn_phase(LAS unsigned char* lds, const Args& T, int G, int vcu, int tid) {
    const int lane = tid & 63, r32 = lane & 31, hi = lane >> 5, w = __builtin_amdgcn_readfirstlane(tid >> 6);
    LAS float* wsf = (LAS float*)(lds + WSF_OFF) + w * 64;
    LAS bf16* stg = (LAS bf16*)(lds + OST_OFF) + w * 2048;
    const int vlane = ((lane >> 4) & 1) * 32 + (lane & 3) * 8 + (4 * hi + ((lane & 15) >> 2)) * 64;
    const int klane = hi * 1024 + r32 * 16;
    for (int unit = vcu; unit < 512; unit += G) {
        const int hh = unit & 1, n = (unit >> 1) & 31, g = (unit >> 6) & 1, b = unit >> 7;
        const int h = 8 * g + 4 * hh + (w >> 1), rh = w & 1;
        const int row0 = b * SEQ + 128 * n + 64 * rh;
        __syncthreads();
        { const bf16* kc = T.KC + (size_t)(b * CTXL) * KVD + g * 64; const bf16* vc = T.VC + (size_t)(b * CTXL) * KVD + g * 64;
#pragma unroll
          for (int j = 0; j < 4; ++j) {
              dma16(kc + (size_t)(64 * j + lane) * KVD + w * 8, lds + j * SLOT + w * 1024);
              dma16(vc + (size_t)(64 * j + 16 * (w & 3) + (lane >> 2)) * KVD + (w >> 2) * 32 + (lane & 3) * 8, lds + j * SLOT + 8192 + w * 1024); } }
        bf16x8 qr[2][4];
#pragma unroll
        for (int sb = 0; sb < 2; ++sb)
#pragma unroll
            for (int d0 = 0; d0 < 4; ++d0) qr[sb][d0] = *(const bf16x8*)(T.Q + (size_t)(row0 + 32 * sb + r32) * QDIM + h * 64 + d0 * 16 + hi * 8);
        const float sink2 = T.sink[h] * LOG2E;
        float m[2] = {sink2, sink2}, l[2] = {1.f, 1.f};
        f32x16 o[2][2];
#pragma unroll
        for (int sb = 0; sb < 2; ++sb) { o[sb][0] = f32x16{}; o[sb][1] = f32x16{}; }
        asm volatile("s_waitcnt vmcnt(0)" ::: "memory");
        __syncthreads();
#pragma unroll
        for (int sb = 0; sb < 2; ++sb)
            for (int j = 0; j < 4; ++j) tile_step((lptr)lds + j * SLOT + klane, (lptr)lds + j * SLOT + 8192 + vlane, qr[sb], o[sb], m[sb], l[sb], wsf, r32, hi, false, 0);
        __syncthreads();
        { const int kr0 = 128 * (n - 1);
#pragma unroll
          for (int j = 0; j < 6; ++j) { const int kr = kr0 + 64 * j;
              if (kr >= 0 && kr < SEQ) {
                  const bf16* kp = T.K + (size_t)(b * SEQ + kr) * KVD + g * 64; const bf16* vq = T.V + (size_t)(b * SEQ + kr) * KVD + g * 64;
                  dma16(kp + (size_t)lane * KVD + w * 8, lds + j * SLOT + w * 1024);
                  dma16(vq + (size_t)(16 * (w & 3) + (lane >> 2)) * KVD + (w >> 2) * 32 + (lane & 3) * 8, lds + j * SLOT + 8192 + w * 1024); } } }
        asm volatile("s_waitcnt vmcnt(0)" ::: "memory");
        __syncthreads();
#pragma unroll
        for (int sb = 0; sb < 2; ++sb)
            for (int j = rh; j < rh + 5; ++j) { const int kr = 128 * (n - 1) + 64 * j;
                if (kr >= 0 && kr < SEQ) tile_step((lptr)lds + j * SLOT + klane, (lptr)lds + j * SLOT + 8192 + vlane, qr[sb], o[sb], m[sb], l[sb], wsf, r32, hi, (j == rh) || (j == rh + 4), 64 * j - (64 * rh + 32 * sb + r32) + 4 * hi); }
#pragma unroll
        for (int sb = 0; sb < 2; ++sb) {
            if (hi == 0) wsf[r32] = 1.0f / l[sb];
#pragma unroll
            for (int k = 0; k < 4; ++k) { const f32x4 a = *(const LAS f32x4*)(wsf + 8 * k + 4 * hi);
#pragma unroll
                for (int e = 0; e < 4; ++e) { const int orow = 8 * k + 4 * hi + e;
                    stg[orow * 64 + r32] = (bf16)f2bf(o[sb][0][4 * k + e] * a[e]); stg[orow * 64 + 32 + r32] = (bf16)f2bf(o[sb][1][4 * k + e] * a[e]); } }
            bf16* Ow = T.O + (size_t)(row0 + 32 * sb) * QDIM + h * 64;
#pragma unroll
            for (int i = 0; i < 4; ++i) { const int row = i * 8 + (lane >> 3), ch = lane & 7; const v4u v = *(const LAS v4u*)(stg + row * 64 + ch * 8); *(v4u*)(Ow + (size_t)row * QDIM + ch * 8) = v; }
        }
    }
    __syncthreads();
}
}

struct Params { const float* in[18]; float* out; unsigned char* ws; };
__global__ void __launch_bounds__(NWAVES * 64, 2) fwd_kernel(Params prm) {
    extern __shared__ __attribute__((aligned(16))) unsigned char lds[];
    Frame F;
    F.lds = (LAS unsigned char*)lds;
    F.MISC = (volatile LAS unsigned*)(F.lds + MISC_OFF);
    F.tid = threadIdx.x; F.lane = F.tid & 63; F.wave = __builtin_amdgcn_readfirstlane(F.tid >> 6);
    F.G = gridDim.x; { const int bx = blockIdx.x; F.vcu = (F.G % 8 == 0) ? (bx % 8) * (F.G / 8) + bx / 8 : bx; }
    F.ws = prm.ws; F.out = prm.out;
#pragma unroll
    for (int i = 0; i < 18; ++i) F.in[i] = prm.in[i];
    F.ctl = (gu32*)(F.ws + WS_CTL);
    for (int u = F.tid; u < (LDS_BYTES - LDSCTL_OFF) / 4; u += NWAVES * 64) ((LAS unsigned*)(F.lds + LDSCTL_OFF))[u] = 0u;
    __syncthreads();
    XcdBarrier bar = xcd_barrier_post((unsigned*)(F.ctl + CW_BAR), F.MISC + 8);
#define GRID_BAR() xcd_barrier(bar)
    unsigned char* ws = F.ws;
    float* MOD = (float*)(ws + WS_MOD);
    float* CX = (float*)(ws + WS_CX);
    bf16* XN = (bf16*)(ws + WS_XN);
    bf16 *U = (bf16*)(ws + WS_U), *DP = (bf16*)(ws + WS_DP), *Y1 = (bf16*)(ws + WS_Y1), *H = (bf16*)(ws + WS_H);
    bf16 *Qb = (bf16*)(ws + WS_Q), *Kb = (bf16*)(ws + WS_K), *Vb = (bf16*)(ws + WS_V), *KC = (bf16*)(ws + WS_KC), *VC = (bf16*)(ws + WS_VC), *Ob = (bf16*)(ws + WS_O);
    float* RAW = (float*)(ws + WS_RAW);
    const bf16 *Win_t = (const bf16*)(ws + WS_WIN), *Wgrp_t = (const bf16*)(ws + WS_WGRP), *Wout_t = (const bf16*)(ws + WS_WOUT), *Wqkv_t = (const bf16*)(ws + WS_WQKV), *Wo_t = (const bf16*)(ws + WS_WO);
    const bf16 *W1_t = (const bf16*)(ws + WS_W1), *W2_t = (const bf16*)(ws + WS_W2);
    const float* MOD0 = MOD; const float* MOD1 = MOD + 5 * NMOD * D;

    p0_mod(F); p0_rope_table(F); p0_transposes(F);
    GRID_BAR();
#if FAST_GEMM
#define GEMM_RUN(EpiT, SchedT, g, S, E) pg8::gemm_phase<EpiT, SchedT, true, true>(F.lds, g, S, E)
    const int cid = (int)blockIdx.x;
#endif
    norm_mod_pass(F, F.in[I_X], F.in[I_CTX], MA, F.in[I_NMIXG], MOD0, 0, 1, XN);
    GRID_BAR();
#if FAST_GEMM
    { pg8::Gemm g{XN, Win_t, D, D, D, 0}; pg8::StaticOrder S; S.init(MA, D, F.G, cid); pg8::EpiStore<0> E{U, D, nullptr}; GEMM_RUN(pg8::EpiStore<0>, pg8::StaticOrder, g, S, E); }
#else
    naive_gemm(F, XN, D, Win_t, D, MA, D, D, NEpiBf16{U, D, 0, nullptr});
#endif
    GRID_BAR();
    pool_pass(F, U, DP);
    GRID_BAR();
#if FAST_GEMM
    { pg8::Gemm g{DP, Wgrp_t, 256, D, 256, 256}; pg8::StaticOrder S; S.init(MA, D, F.G, cid); pg8::EpiStore<0> E{Y1, D, F.in[I_PSCALE]}; GEMM_RUN(pg8::EpiStore<0>, pg8::StaticOrder, g, S, E); }
#else
    for (int g = 0; g < 4; ++g) naive_gemm(F, DP + g * 256, D, Wgrp_t + (size_t)g * 65536, 256, MA, 256, 256, NEpiBf16{Y1, D, g * 256, F.in[I_PSCALE]});
#endif
    GRID_BAR();
#if FAST_GEMM
    { pg8::Gemm g{Y1, Wout_t, D, D, D, 0}; pg8::StaticOrder S; S.init(MA, D, F.G, cid); pg8::EpiRes E{F.in[I_X], F.in[I_CTX], F.out, CX, MOD0 + 2 * D}; GEMM_RUN(pg8::EpiRes, pg8::StaticOrder, g, S, E); }
#else
    naive_gemm(F, Y1, D, Wout_t, D, MA, D, D, NEpiRes{F.in[I_X], F.in[I_CTX], F.out, CX, MOD0 + 2 * D});
#endif
    GRID_BAR();
    norm_mod_pass(F, F.out, CX, MA, F.in[I_NMLPG], MOD0, 3, 4, XN);
    GRID_BAR();
#if FAST_GEMM
    { pg8::Gemm g{XN, W1_t, D, D, D, 0}; pg8::StaticOrder S; S.init(MA, FF, F.G, cid); pg8::EpiStore<1> E{H, FF, nullptr}; GEMM_RUN(pg8::EpiStore<1>, pg8::StaticOrder, g, S, E); }
#else
    naive_gemm(F, XN, D, W1_t, D, MA, FF, D, NEpiSqRelu{H, FF});
#endif
    GRID_BAR();
#if FAST_GEMM
    { pg8::Gemm g{H, W2_t, FF, FF, FF, 0}; pg8::StaticOrder S; S.init(MA, D, F.G, cid); pg8::EpiRes E{F.out, CX, F.out, CX, MOD0 + 5 * D}; GEMM_RUN(pg8::EpiRes, pg8::StaticOrder, g, S, E); }
#else
    naive_gemm(F, H, FF, W2_t, FF, MA, D, FF, NEpiRes{F.out, CX, F.out, CX, MOD0 + 5 * D});
#endif
    GRID_BAR();
    norm_mod_pass(F, F.out, CX, MA, F.in[I_NMIXG] + D, MOD1, 0, 1, XN);
    GRID_BAR();
#if FAST_GEMM
    { pg8::Gemm g{XN, Wqkv_t, D, D, D, 0}; pg8::QkvOrder S; S.init(F.G, cid); pg8::EpiQkv E{Qb, Kb, Vb, KC, VC, (const float*)(ws + WS_ROPE), QS}; GEMM_RUN(pg8::EpiQkv, pg8::QkvOrder, g, S, E); }
    GRID_BAR();
#else
    naive_gemm(F, XN, D, Wqkv_t, D, ML, NQKV, D, NEpiQkvLat{RAW, Vb});
    naive_gemm(F, XN + (size_t)ML * D, D, Wqkv_t + (size_t)QDIM * D, D, MC, 256, D, NEpiKvCtx{KC, VC});
    GRID_BAR();
    naive_rope_pass(F, RAW, Qb, Kb);
    GRID_BAR();
#endif
#if FAST_ATTN
    { att::Args AT{Qb, Kb, Vb, KC, VC, Ob, F.in[I_SINK]}; att::attn_phase(F.lds, AT, F.G, F.vcu, F.tid); }
#else
    naive_attention(F, Qb, Kb, Vb, KC, VC, Ob);
#endif
    GRID_BAR();
#if FAST_GEMM
    { pg8::Gemm g{Ob, Wo_t, D, D, D, 0}; pg8::StaticOrder S; S.init(ML, D, F.G, cid); pg8::EpiRes E{F.out, CX, F.out, CX, MOD1 + 2 * D}; GEMM_RUN(pg8::EpiRes, pg8::StaticOrder, g, S, E); }
#else
    naive_gemm(F, Ob, D, Wo_t, D, ML, D, D, NEpiRes{F.out, CX, F.out, CX, MOD1 + 2 * D});
#endif
    GRID_BAR();
    norm_mod_pass(F, F.out, CX, ML, F.in[I_NMLPG] + D, MOD1, 3, 4, XN);
    GRID_BAR();
#if FAST_GEMM
    { pg8::Gemm g{XN, W1_t + (size_t)D * FF, D, D, D, 0}; pg8::StaticOrder S; S.init(ML, FF, F.G, cid); pg8::EpiStore<1> E{H, FF, nullptr}; GEMM_RUN(pg8::EpiStore<1>, pg8::StaticOrder, g, S, E); }
#else
    naive_gemm(F, XN, D, W1_t + (size_t)D * FF, D, ML, FF, D, NEpiSqRelu{H, FF});
#endif
    GRID_BAR();
#if FAST_GEMM
    { pg8::Gemm g{H, W2_t + (size_t)D * FF, FF, FF, FF, 0}; pg8::StaticOrder S; S.init(ML, D, F.G, cid); pg8::EpiRes E{F.out, CX, F.out, CX, MOD1 + 5 * D}; GEMM_RUN(pg8::EpiRes, pg8::StaticOrder, g, S, E); }
#else
    naive_gemm(F, H, FF, W2_t + (size_t)D * FF, FF, ML, D, FF, NEpiRes{F.out, CX, F.out, CX, MOD1 + 5 * D});
#endif
    GRID_BAR();
    final_norm_pass(F, F.out, F.in[I_FING]);
}

extern "C" void kernel_launch(void* const* d_in, const int* in_sizes, int n_in, void* d_out, int out_size, void* d_ws, size_t ws_size, hipStream_t stream) {
    static int grid = 0;
    if (grid == 0) {
        if (n_in != 18 || in_sizes[0] != ML * D || out_size != ML * D || ws_size < WS_END) { fprintf(stderr, "kernel_launch: unexpected problem shape (n_in %d, in0 %d, out %d, ws %zu); nothing launched\n", n_in, n_in > 0 ? in_sizes[0] : -1, out_size, ws_size); grid = -1; return; }
        int dev = 0, cus = 0;
        if (hipGetDevice(&dev) != hipSuccess || hipDeviceGetAttribute(&cus, hipDeviceAttributeMultiprocessorCount, dev) != hipSuccess) { fprintf(stderr, "kernel_launch: device query failed\n"); grid = -1; return; }
        if (hipFuncSetAttribute((const void*)fwd_kernel, hipFuncAttributeMaxDynamicSharedMemorySize, LDS_BYTES) != hipSuccess) { fprintf(stderr, "kernel_launch: hipFuncSetAttribute failed\n"); grid = -1; return; }
        int per_cu = 0;
        if (hipOccupancyMaxActiveBlocksPerMultiprocessor(&per_cu, (const void*)fwd_kernel, NWAVES * 64, LDS_BYTES) != hipSuccess || per_cu < 1) fprintf(stderr, "kernel_launch: note: occupancy query reports %d workgroups per CU\n", per_cu);
        (void)hipGetLastError();
        grid = cus;
    }
    if (grid < 0) return;
    if (hipMemsetAsync((char*)d_ws + WS_CTL, 0, CTL_ZERO_BYTES, stream) != hipSuccess) { fprintf(stderr, "kernel_launch: memset failed\n"); return; }
    Params a{};
    for (int i = 0; i < 18; ++i) a.in[i] = (const float*)d_in[i];
    a.out = (float*)d_out; a.ws = (unsigned char*)d_ws;
    hipLaunchKernelGGL(fwd_kernel, dim3(grid), dim3(NWAVES * 64), LDS_BYTES, stream, a);
    const hipError_t le = hipPeekAtLastError();
    if (le != hipSuccess) fprintf(stderr, "kernel_launch: launch failed: %s\n", hipGetErrorName(le));
}
```
